# Optimizing an MI355X kernel written in HIP

```python
import jax, jax.numpy as jnp
from jax import lax
import numpy as np

D_MODEL = 1024
BATCH = 16
SEQ = 256
DEPTH = 4
DEC_BATCH = 8
DEC_SEQ = 4096
PAST_LEN = 512

GRID_W = 64
EPS = 1e-6
ROPE_THETA = 10000.0
D_FF = 4 * D_MODEL
CONV_W = 3
Q_BLOCK = 128
N_EVEN = (DEPTH + 1) // 2
N_ODD = DEPTH // 2
GDN_HEADS = D_MODEL // 256
GDN_DK = 128
GDN_DV = 128
GDN_CHUNK = 64
GQA_HEADS = D_MODEL // 256
GQA_KV_HEADS = GQA_HEADS // 2
GQA_DH = 128
SSD_HEADS = D_MODEL // 128
SSD_P = 64
SSD_N = 128
SSD_GROUPS = 2
SSD_CHUNK = 64
SSD_D_INNER = SSD_HEADS * SSD_P
NA_HEADS = D_MODEL // 256
NA_DH = 128
NA_WIN_R = 8
NA_WIN_C = 16

EV_WIDTHS = (GDN_HEADS * GDN_DK, GDN_HEADS * GDN_DK, GDN_HEADS * GDN_DV, GDN_HEADS * GDN_DV,
             2 * GDN_HEADS, 2 * GDN_HEADS,
             GQA_HEADS * GQA_DH, GQA_KV_HEADS * GQA_DH, GQA_KV_HEADS * GQA_DH)
EV_IN = sum(EV_WIDTHS)
EV_MIX = GDN_HEADS * GDN_DV + GQA_HEADS * GQA_DH
OD_WIDTHS = (SSD_D_INNER, SSD_D_INNER, SSD_GROUPS * SSD_N, SSD_GROUPS * SSD_N, 2 * SSD_HEADS,
             NA_HEADS * NA_DH, NA_HEADS * NA_DH, NA_HEADS * NA_DH)
OD_IN = sum(OD_WIDTHS)
OD_MIX = SSD_D_INNER + NA_HEADS * NA_DH

kernel_name = 'hybrid_dit_gdn_gqa_ssd_natten_step'


def rmsnorm(x, w):
    xf = x.astype(jnp.float32)
    y = xf * lax.rsqrt(jnp.mean(xf * xf, axis=-1, keepdims=True) + EPS)
    return (y * w.astype(jnp.float32)).astype(x.dtype)


def l2norm(x):
    xf = x.astype(jnp.float32)
    return (xf * lax.rsqrt(jnp.sum(xf * xf, axis=-1, keepdims=True) + EPS)).astype(x.dtype)


def split_cols(t, widths):
    return jnp.split(t, [int(i) for i in np.cumsum(widths)[:-1]], axis=-1)


def depthwise_conv(x, w):
    pad = CONV_W // 2
    return lax.conv_general_dilated(x, w[:, None, :].astype(x.dtype), (1,), [(pad, pad)],
                                    dimension_numbers=('NWC', 'WIO', 'NWC'),
                                    feature_group_count=x.shape[-1])


def modulate(x, w_pre, shift, scale):
    return rmsnorm(x, w_pre) * (1 + scale) + shift


def rope_angles(n_tokens):
    half = GQA_DH // 2
    inv_freq = ROPE_THETA ** (-jnp.arange(0, half, 2, dtype=jnp.float32) / half)
    t = jnp.arange(n_tokens)
    row = (t // GRID_W).astype(jnp.float32)
    col = (t % GRID_W).astype(jnp.float32)
    return row[:, None] * inv_freq, col[:, None] * inv_freq


def rotate(x, ang):
    m = ang.shape[-1]
    cos = jnp.cos(ang)[None, :, None, :].astype(x.dtype)
    sin = jnp.sin(ang)[None, :, None, :].astype(x.dtype)
    x1, x2 = x[..., :m], x[..., m:]
    return jnp.concatenate([x1 * cos - x2 * sin, x2 * cos + x1 * sin], axis=-1)


def axial_rope(x, ang_r, ang_c):
    half = x.shape[-1] // 2
    return jnp.concatenate([rotate(x[..., :half], ang_r), rotate(x[..., half:], ang_c)], axis=-1)


def block_attention(q, k, v):
    bsz, seq_len, heads, dh = q.shape
    kv_heads = k.shape[2]
    rep = heads // kv_heads
    nb = seq_len // Q_BLOCK
    qb = q.reshape(bsz, nb, Q_BLOCK, kv_heads, rep, dh).transpose(1, 0, 2, 3, 4, 5)

    def one_block(q_blk):
        s = jnp.einsum('bqgrd,bkgd->bgrqk', q_blk, k, preferred_element_type=jnp.float32) * dh ** -0.5
        p = jax.nn.softmax(s, axis=-1).astype(v.dtype)
        return jnp.einsum('bgrqk,bkgd->bqgrd', p, v)

    o = lax.map(one_block, qb)
    return o.transpose(1, 0, 2, 3, 4, 5).reshape(bsz, seq_len, heads, dh)


def neighbourhood_attention(q, k, v, k_ctx, v_ctx, rpb):
    bsz, seq_len, heads, dh = q.shape
    rows = seq_len // GRID_W
    win_r = min(NA_WIN_R, rows)
    qg = q.reshape(bsz, rows, GRID_W, heads, dh)
    kg = k.reshape(bsz, rows, GRID_W, heads, dh)
    vg = v.reshape(bsz, rows, GRID_W, heads, dh)
    col = jnp.arange(GRID_W)
    col_start = jnp.clip(col - NA_WIN_C // 2, 0, GRID_W - NA_WIN_C)
    col_idx = col_start[:, None] + jnp.arange(NA_WIN_C)[None, :]
    col_off = col_idx - col[:, None] + (NA_WIN_C - 1)
    bias_col = rpb.astype(jnp.float32)[:, :, col_off]
    scale = dh ** -0.5

    def one_row(r):
        r0 = jnp.clip(r - win_r // 2, 0, rows - win_r)
        q_r = lax.dynamic_index_in_dim(qg, r, axis=1, keepdims=False)
        k_rows = lax.dynamic_slice_in_dim(kg, r0, win_r, axis=1)
        v_rows = lax.dynamic_slice_in_dim(vg, r0, win_r, axis=1)
        k_nb = k_rows[:, :, col_idx]
        v_nb = v_rows[:, :, col_idx]
        row_off = r0 + jnp.arange(win_r) - r + (NA_WIN_R - 1)
        bias = bias_col[:, row_off].transpose(0, 2, 1, 3)
        s_loc = jnp.einsum('bqhd,brqchd->bhqrc', q_r, k_nb, preferred_element_type=jnp.float32) * scale + bias[None]
        s_ctx = jnp.einsum('bqhd,bkhd->bhqk', q_r, k_ctx, preferred_element_type=jnp.float32) * scale
        n_loc = win_r * NA_WIN_C
        s = jnp.concatenate([s_loc.reshape(bsz, heads, GRID_W, n_loc), s_ctx], axis=-1)
        p = jax.nn.softmax(s, axis=-1).astype(v.dtype)
        p_loc = p[..., :n_loc].reshape(bsz, heads, GRID_W, win_r, NA_WIN_C)
        p_ctx = p[..., n_loc:]
        return jnp.einsum('bhqrc,brqchd->bqhd', p_loc, v_nb) + jnp.einsum('bhqk,bkhd->bqhd', p_ctx, v_ctx)

    o = lax.map(one_row, jnp.arange(rows))
    return o.transpose(1, 0, 2, 3, 4).reshape(bsz, seq_len, heads, dh)


def gated_delta_chunked(q, k, v, g, beta, s0):
    bsz, seq_len, heads, _ = q.shape
    dv = v.shape[-1]
    nc = seq_len // GDN_CHUNK
    f32 = jnp.float32

    def chunks(t):
        return t.astype(f32).reshape(bsz, nc, GDN_CHUNK, heads, -1).transpose(0, 1, 3, 2, 4)

    q, k, v = chunks(q), chunks(k), chunks(v)
    g = g.astype(f32).reshape(bsz, nc, GDN_CHUNK, heads).transpose(0, 1, 3, 2)
    beta = beta.astype(f32).reshape(bsz, nc, GDN_CHUNK, heads).transpose(0, 1, 3, 2)
    gc = jnp.cumsum(g, axis=-1)
    incl = jnp.tril(jnp.ones((GDN_CHUNK, GDN_CHUNK), dtype=bool))
    strict = jnp.tril(jnp.ones((GDN_CHUNK, GDN_CHUNK), dtype=bool), -1)
    decay = jnp.exp(jnp.where(incl, gc[..., :, None] - gc[..., None, :], -jnp.inf))
    kb = k * beta[..., None]
    a_mat = jnp.where(strict, jnp.einsum('bnhik,bnhjk->bnhij', kb, k) * decay, 0.0)
    t_mat = a_mat + jnp.eye(GDN_CHUNK, dtype=f32)
    rhs = jnp.concatenate([v * beta[..., None], kb * jnp.exp(gc)[..., None]], axis=-1)
    sol = lax.linalg.triangular_solve(t_mat, rhs, left_side=True, lower=True, unit_diagonal=True)
    u, w = sol[..., :dv], sol[..., dv:]
    qk = jnp.where(incl, jnp.einsum('bnhik,bnhjk->bnhij', q, k) * decay, 0.0)
    q_dec = q * jnp.exp(gc)[..., None]
    k_dec = k * jnp.exp(gc[..., -1:] - gc)[..., None]
    g_tot = jnp.exp(gc[..., -1])

    def step(s, xs):
        u_c, w_c, qk_c, qd_c, kd_c, gt_c = xs
        v_new = u_c - jnp.einsum('bhck,bhkv->bhcv', w_c, s)
        o = jnp.einsum('bhck,bhkv->bhcv', qd_c, s) + jnp.einsum('bhij,bhjv->bhiv', qk_c, v_new)
        s = s * gt_c[..., None, None] + jnp.einsum('bhck,bhcv->bhkv', kd_c, v_new)
        return s, o

    xs = tuple(jnp.moveaxis(t, 1, 0) for t in (u, w, qk, q_dec, k_dec, g_tot))
    s_fin, o = lax.scan(step, s0.astype(f32), xs)
    o = o.transpose(1, 0, 3, 2, 4).reshape(bsz, seq_len, heads, dv)
    return o, s_fin


def bidir_gated_delta(q, k, v, g, beta, s0):
    flip = lambda t: jnp.flip(t, axis=1)
    o_f, s_f = gated_delta_chunked(q, k, v, g[:, :, 0], beta[:, :, 0], s0[:, 0])
    o_b, s_b = gated_delta_chunked(flip(q), flip(k), flip(v), flip(g[:, :, 1]), flip(beta[:, :, 1]), s0[:, 1])
    return o_f + flip(o_b), jnp.stack([s_f, s_b], axis=1)


def ssd_chunked(x, dt, a, bm, cm, h0):
    bsz, seq_len, heads, p_dim = x.shape
    groups, n_dim = bm.shape[2], bm.shape[3]
    e = heads // groups
    nc = seq_len // SSD_CHUNK
    f32 = jnp.float32
    dtf = dt.astype(f32)
    xf = (x.astype(f32) * dtf[..., None]).reshape(bsz, nc, SSD_CHUNK, groups, e, p_dim)
    la = (dtf * a.astype(f32)).reshape(bsz, nc, SSD_CHUNK, groups, e)
    bc = bm.astype(f32).reshape(bsz, nc, SSD_CHUNK, groups, n_dim)
    cc = cm.astype(f32).reshape(bsz, nc, SSD_CHUNK, groups, n_dim)
    cs = jnp.cumsum(la, axis=2)
    incl = jnp.tril(jnp.ones((SSD_CHUNK, SSD_CHUNK), dtype=bool))[:, :, None, None]
    l_mat = jnp.exp(jnp.where(incl, cs[:, :, :, None] - cs[:, :, None, :], -jnp.inf))
    y_diag = jnp.einsum('bclgn,bcsgn,bclsge,bcsgep->bclgep', cc, bc, l_mat, xf)
    decay_states = jnp.exp(cs[:, :, -1:] - cs)
    states = jnp.einsum('bclgn,bclge,bclgep->bcgepn', bc, decay_states, xf)
    chunk_decay = jnp.exp(cs[:, :, -1])

    def step(h, xs):
        st, cd = xs
        return h * cd[..., None, None] + st, h

    h_fin, h_start = lax.scan(step, h0.astype(f32).reshape(bsz, groups, e, p_dim, n_dim),
                              (jnp.moveaxis(states, 1, 0), jnp.moveaxis(chunk_decay, 1, 0)))
    h_start = jnp.moveaxis(h_start, 0, 1)
    y_off = jnp.einsum('bclgn,bcgepn,bclge->bclgep', cc, h_start, jnp.exp(cs))
    y = (y_diag + y_off).reshape(bsz, seq_len, heads, p_dim)
    return y, h_fin.reshape(bsz, heads, p_dim, n_dim)


def bidir_ssd(x, dt, a, bm, cm, h0):
    flip = lambda t: jnp.flip(t, axis=1)
    y_f, h_f = ssd_chunked(x, dt[:, :, 0], a[0], bm, cm, h0[:, 0])
    y_b, h_b = ssd_chunked(flip(x), flip(dt[:, :, 1]), a[1], flip(bm), flip(cm), h0[:, 1])
    return y_f + flip(y_b), jnp.stack([h_f, h_b], axis=1)


def even_mixer(h, w_in, w_out, conv_w, a_log, dt_bias, gdn_norm, q_norm, k_norm, ang=None, ctx=None):
    bsz, seq_len, _ = h.shape
    qa, ka, va, za, ba, aa, qb, kb, vb = split_cols(h @ w_in, EV_WIDTHS)
    qkv = jax.nn.silu(depthwise_conv(jnp.concatenate([qa, ka, va], axis=-1), conv_w))
    qa, ka, va = split_cols(qkv, EV_WIDTHS[:3])
    qa = l2norm(qa.reshape(bsz, seq_len, GDN_HEADS, GDN_DK)) * GDN_DK ** -0.5
    ka = l2norm(ka.reshape(bsz, seq_len, GDN_HEADS, GDN_DK))
    va = va.reshape(bsz, seq_len, GDN_HEADS, GDN_DV)
    beta = jax.nn.sigmoid(ba.astype(jnp.float32)).reshape(bsz, seq_len, 2, GDN_HEADS)
    g = -jnp.exp(a_log.astype(jnp.float32)) * jax.nn.softplus(
        aa.astype(jnp.float32).reshape(bsz, seq_len, 2, GDN_HEADS) + dt_bias.astype(jnp.float32))
    s0 = jnp.zeros((bsz, 2, GDN_HEADS, GDN_DK, GDN_DV), jnp.float32) if ctx is None else ctx[0]
    o_a, s_a = bidir_gated_delta(qa, ka, va, g, beta, s0)
    o_a = rmsnorm(o_a.astype(h.dtype), gdn_norm) * jax.nn.silu(za.reshape(bsz, seq_len, GDN_HEADS, GDN_DV))
    qb = rmsnorm(qb.reshape(bsz, seq_len, GQA_HEADS, GQA_DH), q_norm)
    kb = rmsnorm(kb.reshape(bsz, seq_len, GQA_KV_HEADS, GQA_DH), k_norm)
    vb = vb.reshape(bsz, seq_len, GQA_KV_HEADS, GQA_DH)
    if ctx is None:
        o_b = block_attention(qb, kb, vb)
    else:
        o_b = block_attention(axial_rope(qb, *ang),
                              jnp.concatenate([axial_rope(kb, *ang), ctx[1].astype(kb.dtype)], axis=1),
                              jnp.concatenate([vb, ctx[2].astype(vb.dtype)], axis=1))
    y = jnp.concatenate([o_a.reshape(bsz, seq_len, -1), o_b.reshape(bsz, seq_len, -1)], axis=-1) @ w_out
    if ctx is None:
        return y, s_a, kb, vb
    return y


def odd_mixer(h, w_in, w_out, conv_w, conv_b, a_log, dt_bias, d_skip, ssd_norm, rpb, ctx=None):
    bsz, seq_len, _ = h.shape
    z, xc, bc, cc, dt_raw, qd, kd, vd = split_cols(h @ w_in, OD_WIDTHS)
    xbc = jax.nn.silu(depthwise_conv(jnp.concatenate([xc, bc, cc], axis=-1), conv_w) + conv_b)
    xc, bc, cc = split_cols(xbc, OD_WIDTHS[1:4])
    xh = xc.reshape(bsz, seq_len, SSD_HEADS, SSD_P)
    bm = bc.reshape(bsz, seq_len, SSD_GROUPS, SSD_N)
    cm = cc.reshape(bsz, seq_len, SSD_GROUPS, SSD_N)
    dt = jax.nn.softplus(dt_raw.astype(jnp.float32).reshape(bsz, seq_len, 2, SSD_HEADS) + dt_bias.astype(jnp.float32))
    a = -jnp.exp(a_log.astype(jnp.float32))
    h0 = jnp.zeros((bsz, 2, SSD_HEADS, SSD_P, SSD_N), jnp.float32) if ctx is None else ctx[0]
    y_c, s_c = bidir_ssd(xh, dt, a, bm, cm, h0)
    y_c = y_c + xh.astype(jnp.float32) * d_skip.astype(jnp.float32)[:, None]
    y_c = rmsnorm((y_c.reshape(bsz, seq_len, SSD_D_INNER) * jax.nn.silu(z.astype(jnp.float32))).astype(h.dtype), ssd_norm)
    qd = qd.reshape(bsz, seq_len, NA_HEADS, NA_DH)
    kd = kd.reshape(bsz, seq_len, NA_HEADS, NA_DH)
    vd = vd.reshape(bsz, seq_len, NA_HEADS, NA_DH)
    if ctx is None:
        o_d = block_attention(qd, kd, vd)
    else:
        o_d = neighbourhood_attention(qd, kd, vd, ctx[1].astype(kd.dtype), ctx[2].astype(vd.dtype), rpb)
    y = jnp.concatenate([y_c, o_d.reshape(bsz, seq_len, -1)], axis=-1) @ w_out
    if ctx is None:
        return y, s_c, kd, vd
    return y


def sq_relu_mlp(h, w1, w2):
    return jnp.square(jax.nn.relu(h @ w1)) @ w2


def setup_inputs(seed: int = 0) -> dict:
    key = jax.random.key(seed)
    ks = iter(jax.random.split(key, 48))
    nrm = lambda shape, s: jax.random.normal(next(ks), shape, jnp.float32) * s

    def a_log_init(shape):
        return jnp.log(jax.random.uniform(next(ks), shape, jnp.float32, 1.0, 16.0))

    def dt_bias_init(shape):
        dt = jnp.exp(jax.random.uniform(next(ks), shape, jnp.float32, np.log(1e-3), np.log(1e-1)))
        return dt + jnp.log(-jnp.expm1(-dt))

    return {
        'x_prompt': nrm((BATCH, SEQ, D_MODEL), 1.0),
        'x_sample': nrm((DEC_BATCH, DEC_SEQ, D_MODEL), 1.0),
        'state_gdn': nrm((DEC_BATCH, N_EVEN, 2, GDN_HEADS, GDN_DK, GDN_DV), 0.1),
        'cache_gqa_k': nrm((DEC_BATCH, N_EVEN, PAST_LEN, GQA_KV_HEADS, GQA_DH), 1.0),
        'cache_gqa_v': nrm((DEC_BATCH, N_EVEN, PAST_LEN, GQA_KV_HEADS, GQA_DH), 1.0),
        'state_ssd': nrm((DEC_BATCH, N_ODD, 2, SSD_HEADS, SSD_P, SSD_N), 0.1),
        'cache_na_k': nrm((DEC_BATCH, N_ODD, PAST_LEN, NA_HEADS, NA_DH), 1.0),
        'cache_na_v': nrm((DEC_BATCH, N_ODD, PAST_LEN, NA_HEADS, NA_DH), 1.0),
        'c': nrm((DEC_BATCH, D_MODEL), 1.0),
        'c_ctx': nrm((D_MODEL,), 1.0),
        'ada_w': nrm((DEPTH, D_MODEL, 6 * D_MODEL), D_MODEL ** -0.5),
        'ada_b': nrm((DEPTH, 6 * D_MODEL), 0.01),
        'norm_mix_pre': 1.0 + nrm((DEPTH, D_MODEL), 0.1),
        'norm_mix_post': 1.0 + nrm((DEPTH, D_MODEL), 0.1),
        'norm_mlp_pre': 1.0 + nrm((DEPTH, D_MODEL), 0.1),
        'norm_mlp_post': 1.0 + nrm((DEPTH, D_MODEL), 0.1),
        'mlp_w1': nrm((DEPTH, D_MODEL, D_FF), D_MODEL ** -0.5),
        'mlp_w2': nrm((DEPTH, D_FF, D_MODEL), D_FF ** -0.5),
        'ev_w_in': nrm((N_EVEN, D_MODEL, EV_IN), D_MODEL ** -0.5),
        'ev_w_out': nrm((N_EVEN, EV_MIX, D_MODEL), EV_MIX ** -0.5),
        'gdn_conv': nrm((N_EVEN, CONV_W, 2 * GDN_HEADS * GDN_DK + GDN_HEADS * GDN_DV), CONV_W ** -0.5),
        'gdn_a_log': a_log_init((N_EVEN, 2, GDN_HEADS)),
        'gdn_dt_bias': dt_bias_init((N_EVEN, 2, GDN_HEADS)),
        'gdn_norm': 1.0 + nrm((N_EVEN, GDN_DV), 0.1),
        'gqa_q_norm': 1.0 + nrm((N_EVEN, GQA_DH), 0.1),
        'gqa_k_norm': 1.0 + nrm((N_EVEN, GQA_DH), 0.1),
        'od_w_in': nrm((N_ODD, D_MODEL, OD_IN), D_MODEL ** -0.5),
        'od_w_out': nrm((N_ODD, OD_MIX, D_MODEL), OD_MIX ** -0.5),
        'ssd_conv': nrm((N_ODD, CONV_W, SSD_D_INNER + 2 * SSD_GROUPS * SSD_N), CONV_W ** -0.5),
        'ssd_conv_b': nrm((N_ODD, SSD_D_INNER + 2 * SSD_GROUPS * SSD_N), 0.02),
        'ssd_a_log': a_log_init((N_ODD, 2, SSD_HEADS)),
        'ssd_dt_bias': dt_bias_init((N_ODD, 2, SSD_HEADS)),
        'ssd_d': 1.0 + nrm((N_ODD, SSD_HEADS), 0.1),
        'ssd_norm': 1.0 + nrm((N_ODD, SSD_D_INNER), 0.1),
        'na_rpb': nrm((N_ODD, NA_HEADS, 2 * NA_WIN_R - 1, 2 * NA_WIN_C - 1), 0.1),
    }


def reference(x_prompt, x_sample, state_gdn, cache_gqa_k, cache_gqa_v, state_ssd, cache_na_k, cache_na_v,
              c, c_ctx, ada_w, ada_b, norm_mix_pre, norm_mix_post, norm_mlp_pre, norm_mlp_post,
              mlp_w1, mlp_w2, ev_w_in, ev_w_out, gdn_conv, gdn_a_log, gdn_dt_bias, gdn_norm,
              gqa_q_norm, gqa_k_norm, od_w_in, od_w_out, ssd_conv, ssd_conv_b, ssd_a_log, ssd_dt_bias,
              ssd_d, ssd_norm, na_rpb):
    ang = rope_angles(x_sample.shape[1])
    xp, xs = x_prompt, x_sample
    new_gdn, new_gk, new_gv, new_ssd, new_nk, new_nv = [], [], [], [], [], []
    for i in range(DEPTH):
        m_ctx = (jax.nn.silu(c_ctx) @ ada_w[i] + ada_b[i])[None, None, :]
        m_lat = (jax.nn.silu(c) @ ada_w[i] + ada_b[i])[:, None, :]
        sh1c, sc1c, g1c, sh2c, sc2c, g2c = jnp.split(m_ctx, 6, axis=-1)
        sh1l, sc1l, g1l, sh2l, sc2l, g2l = jnp.split(m_lat, 6, axis=-1)
        hc = modulate(xp, norm_mix_pre[i], sh1c, sc1c)
        hl = modulate(xs, norm_mix_pre[i], sh1l, sc1l)
        j = i // 2
        if i % 2 == 0:
            ew = (ev_w_in[j], ev_w_out[j], gdn_conv[j], gdn_a_log[j], gdn_dt_bias[j], gdn_norm[j],
                  gqa_q_norm[j], gqa_k_norm[j])
            yc, s_a, k_b, v_b = even_mixer(hc, *ew)
            yl = even_mixer(hl, *ew, ang=ang, ctx=(state_gdn[:, j], cache_gqa_k[:, j], cache_gqa_v[:, j]))
            new_gdn.append(s_a)
            new_gk.append(k_b)
            new_gv.append(v_b)
        else:
            ow = (od_w_in[j], od_w_out[j], ssd_conv[j], ssd_conv_b[j], ssd_a_log[j], ssd_dt_bias[j],
                  ssd_d[j], ssd_norm[j], na_rpb[j])
            yc, s_c, k_d, v_d = odd_mixer(hc, *ow)
            yl = odd_mixer(hl, *ow, ctx=(state_ssd[:, j], cache_na_k[:, j], cache_na_v[:, j]))
            new_ssd.append(s_c)
            new_nk.append(k_d)
            new_nv.append(v_d)
        xp = xp + g1c * rmsnorm(yc, norm_mix_post[i])
        xs = xs + g1l * rmsnorm(yl, norm_mix_post[i])
        xp = xp + g2c * rmsnorm(sq_relu_mlp(modulate(xp, norm_mlp_pre[i], sh2c, sc2c), mlp_w1[i], mlp_w2[i]), norm_mlp_post[i])
        xs = xs + g2l * rmsnorm(sq_relu_mlp(modulate(xs, norm_mlp_pre[i], sh2l, sc2l), mlp_w1[i], mlp_w2[i]), norm_mlp_post[i])
    return (xp, xs, jnp.stack(new_gdn, axis=1), jnp.stack(new_gk, axis=1), jnp.stack(new_gv, axis=1),
            jnp.stack(new_ssd, axis=1), jnp.stack(new_nk, axis=1), jnp.stack(new_nv, axis=1))
```

```cpp
#include <hip/hip_runtime.h>
#include <hip/hip_cooperative_groups.h>
#include <cstdio>
namespace cg = cooperative_groups;
#ifndef PROBE
#define PROBE 0
#endif

typedef unsigned short bf;
using bf16x8 = __attribute__((ext_vector_type(8))) short;
using s16x4  = __attribute__((ext_vector_type(4))) short;
using f32x4  = __attribute__((ext_vector_type(4))) float;
#define DI __device__ __forceinline__
#define MFMA16(a, b, c) __builtin_amdgcn_mfma_f32_16x16x32_bf16((a), (b), (c), 0, 0, 0)
#define UNROLL _Pragma("unroll")

constexpr int TCTX = 4096, TALL = 36864, PLD = 3072;
constexpr float EPSF = 1e-6f;
constexpr int SMEM_BYTES = 73728;

constexpr size_t OFF_WIN  = 0;
constexpr size_t OFF_WOUT = OFF_WIN + 6553600;
constexpr size_t OFF_W1   = OFF_WOUT + 2097152;
constexpr size_t OFF_W2   = OFF_W1 + 8388608;
constexpr size_t OFF_MOD  = OFF_W2 + 8388608;
constexpr size_t OFF_ROPE = OFF_MOD + 884736;
constexpr size_t OFF_CTR  = OFF_ROPE + 16384;
constexpr size_t OFF_XBAR = OFF_CTR + 4096;
constexpr size_t OFF_RX   = OFF_XBAR + 16384;
constexpr size_t OFF_H    = OFF_RX + 75497472;
constexpr size_t OFF_P    = OFF_RX + 150994944;
constexpr size_t OFF_GATES= OFF_P + 226492416;
constexpr size_t OFF_BG   = OFF_GATES + 2359296;
constexpr size_t OFF_TINV = OFF_BG + 2359296;
constexpr size_t OFF_GC   = OFF_TINV + 37748736;
constexpr size_t OFF_KB   = OFF_GC + 1179648;
constexpr size_t OFF_VT   = OFF_KB + 41943040;
constexpr size_t WS_END   = OFF_VT + 41943040;

constexpr size_t OUT_GDN = 37748736, OUT_GK = 41943040, OUT_GV = 44040192, OUT_SSD = 46137344,
                 OUT_NK = 50331648, OUT_NV = 54525952;

struct Params {
  const float *x_prompt, *x_sample, *state_gdn, *cgk, *cgv, *state_ssd, *cnk, *cnv, *c, *c_ctx, *ada_w, *ada_b,
      *n_mix_pre, *n_mix_post, *n_mlp_pre, *n_mlp_post, *w1, *w2, *ev_in, *ev_out, *gdn_conv, *gdn_alog, *gdn_dtb,
      *gdn_norm, *q_norm, *k_norm, *od_in, *od_out, *ssd_conv, *ssd_conv_b, *ssd_alog, *ssd_dtb, *ssd_d, *ssd_norm, *rpb;
  float* out;
  char* ws;
};

DI int tid_() { int t = threadIdx.x & 255; asm volatile("" : "+v"(t)); return t; }
DI int tid512_() { int t = threadIdx.x; asm volatile("" : "+v"(t)); return t; }
typedef __bf16 bf16x2_t __attribute__((ext_vector_type(2)));
typedef float f32x2_t __attribute__((ext_vector_type(2)));
DI unsigned cvtpk(float a, float b) { f32x2_t f = {a, b}; bf16x2_t h = __builtin_convertvector(f, bf16x2_t); return __builtin_bit_cast(unsigned, h); }
DI bf f2bf(float x) { return (bf)(cvtpk(x, x) & 0xffffu); }
DI float bf2f(bf b) { return __uint_as_float(((unsigned)b) << 16); }
DI float bflo(unsigned u) { return __uint_as_float(u << 16); }
DI float bfhi(unsigned u) { return __uint_as_float(u & 0xffff0000u); }
DI unsigned packbf(float a, float b) { return cvtpk(a, b); }
DI float silu(float v) { return v / (1.f + __expf(-v)); }
DI float softplus(float v) { return v > 20.f ? v : log1pf(expf(v)); }
DI float wave_sum(float v) { UNROLL for (int o = 32; o >= 1; o >>= 1) v += __shfl_xor(v, o); return v; }
DI s16x4 pack4(f32x4 v) { const unsigned a = cvtpk(v[0], v[1]), b = cvtpk(v[2], v[3]); using u32x2 = __attribute__((ext_vector_type(2))) unsigned; u32x2 t = {a, b}; return __builtin_bit_cast(s16x4, t); }
DI bf16x8 cat8(s16x4 lo, s16x4 hi) { return __builtin_shufflevector(lo, hi, 0, 1, 2, 3, 4, 5, 6, 7); }
DI void unpack8(bf16x8 v, float* f) { UNROLL for (int e = 0; e < 8; ++e) f[e] = bf2f((bf)v[e]); }


DI void half_barrier(int* ctr, int& gen, int lane) {
  asm volatile("s_waitcnt vmcnt(0) lgkmcnt(0)" ::: "memory");
  gen += 4;
  if (lane == 0) {
    __hip_atomic_fetch_add(ctr, 1, __ATOMIC_RELAXED, __HIP_MEMORY_SCOPE_WORKGROUP);
    while (__hip_atomic_load(ctr, __ATOMIC_RELAXED, __HIP_MEMORY_SCOPE_WORKGROUP) < gen) __builtin_amdgcn_s_sleep(1);
  }
  asm volatile("s_waitcnt lgkmcnt(0)" ::: "memory");
}

DI void bar_lds() { asm volatile("s_waitcnt lgkmcnt(0)" ::: "memory"); __builtin_amdgcn_s_barrier(); asm volatile("" ::: "memory"); }

DI void convert_tile(char* smem, const float* src, int ldsrc, int gs, bf* dst, int K, int n0, int k0, int nrows) {
  float* tile = (float*)smem;
  const int tid = tid_();
  const int kr = tid >> 2, nc = (tid & 3) * 16;
  const int n = n0 + nc;
  int srcn = n;
  if (gs >= 0) srcn = (n < gs) ? n : (n < 3072 ? n + 16 : (n < 3088 ? gs + n - 3072 : -1));
  UNROLL for (int e4 = 0; e4 < 4; ++e4) {
    float4 v = make_float4(0.f, 0.f, 0.f, 0.f);
    if (srcn >= 0) v = *(const float4*)(src + (size_t)(k0 + kr) * ldsrc + srcn + e4 * 4);
    float* t = tile + kr * 65 + nc + e4 * 4;
    t[0] = v.x; t[1] = v.y; t[2] = v.z; t[3] = v.w;
  }
  __syncthreads();
  const int nn = tid >> 2, ks = (tid & 3) * 16;
  bf16x8 o0, o1;
  UNROLL for (int e = 0; e < 8; ++e) { o0[e] = (short)f2bf(tile[(ks + e) * 65 + nn]); o1[e] = (short)f2bf(tile[(ks + 8 + e) * 65 + nn]); }
  bf* d = nrows ? dst + ((size_t)((k0 + ks) >> 5) * nrows + n0 + nn) * 32 + ((k0 + ks) & 31)
                : dst + (size_t)(n0 + nn) * K + k0 + ks;
  *(bf16x8*)d = o0; *(bf16x8*)(d + 8) = o1;
}

DI void convert_item(char* smem, const Params& p, int layer, int item) {
  const int j = layer >> 1; const bool even = !(layer & 1);
  if (item < 800) {
    const float* src = (even ? p.ev_in : p.od_in) + (size_t)j * 1024 * 3088;
    convert_tile(smem, src, 3088, even ? 2048 : 1536, (bf*)(p.ws + OFF_WIN), 1024, (item >> 4) * 64, (item & 15) * 64, 3200);
  } else if (item < 1056) {
    item -= 800;
    const float* src = (even ? p.ev_out : p.od_out) + (size_t)j * 1024 * 1024;
    convert_tile(smem, src, 1024, -1, (bf*)(p.ws + OFF_WOUT), 1024, (item >> 4) * 64, (item & 15) * 64, 0);
  } else if (item < 2080) {
    item -= 1056;
    convert_tile(smem, p.w1 + (size_t)layer * 1024 * 4096, 4096, -1, (bf*)(p.ws + OFF_W1), 1024, (item >> 4) * 64, (item & 15) * 64, 4096);
  } else {
    item -= 2080;
    convert_tile(smem, p.w2 + (size_t)layer * 4096 * 1024, 1024, -1, (bf*)(p.ws + OFF_W2), 4096, (item >> 6) * 64, (item & 63) * 64, 1024);
  }
}

DI void mod_item(char* smem, const Params& p, int item) {
  const int l = item / 96, cb = item % 96, tid = tid_();
  float* sc = (float*)smem;
  float* red = sc + 9216;
  for (int i = tid; i < 9216; i += 256) {
    const int row = i >> 10, k = i & 1023;
    const float v = row == 0 ? p.c_ctx[k] : p.c[(row - 1) * 1024 + k];
    sc[i] = v / (1.f + expf(-v));
  }
  __syncthreads();
  const int col = tid & 63, kg = tid >> 6;
  const float* w = p.ada_w + (size_t)l * 1024 * 6144 + cb * 64 + col;
  float acc[9];
  UNROLL for (int r = 0; r < 9; ++r) acc[r] = 0.f;
  for (int k = kg * 256; k < kg * 256 + 256; ++k) {
    const float wv = w[(size_t)k * 6144];
    UNROLL for (int r = 0; r < 9; ++r) acc[r] += sc[r * 1024 + k] * wv;
  }
  UNROLL for (int r = 0; r < 9; ++r) red[(kg * 9 + r) * 64 + col] = acc[r];
  __syncthreads();
  if (kg == 0) {
    float* mod = (float*)(p.ws + OFF_MOD);
    UNROLL for (int r = 0; r < 9; ++r)
      mod[(size_t)(l * 9 + r) * 6144 + cb * 64 + col] =
          red[r * 64 + col] + red[(9 + r) * 64 + col] + red[(18 + r) * 64 + col] + red[(27 + r) * 64 + col] + p.ada_b[l * 6144 + cb * 64 + col];
  }
}

DI void rope_item(const Params& p) {
  float* tab = (float*)(p.ws + OFF_ROPE);
  for (int i = tid_(); i < 2048; i += 256) {
    const int pos = i >> 5, f = i & 31;
    const float inv = powf(10000.f, -(float)f / 32.f);
    const float ang = (float)pos * inv;
    tab[i] = cosf(ang); tab[2048 + i] = sinf(ang);
  }
}

template <int MODE>
DI void rowpass(const Params& p, int layer, int row) {
  const int lane = tid_() & 63;
  const int mr = row < TCTX ? 0 : 1 + ((row - TCTX) >> 12);
  float* xr = p.out + (size_t)row * 1024;
  bf* yr = (bf*)(p.ws + OFF_RX) + (size_t)row * 1024;
  const float* mod = (const float*)(p.ws + OFF_MOD);
  const int e0 = lane * 8;
  float x[16];
  {
    const float* src = xr;
    if (MODE == 0) src = row < TCTX ? p.x_prompt + (size_t)row * 1024 : p.x_sample + (size_t)(row - TCTX) * 1024;
    UNROLL for (int hh = 0; hh < 2; ++hh) UNROLL for (int v4 = 0; v4 < 2; ++v4) {
      const float4 v = *(const float4*)(src + hh * 512 + e0 + v4 * 4);
      x[hh * 8 + v4 * 4 + 0] = v.x; x[hh * 8 + v4 * 4 + 1] = v.y; x[hh * 8 + v4 * 4 + 2] = v.z; x[hh * 8 + v4 * 4 + 3] = v.w;
    }
  }
  if (MODE != 0) {
    float y[16];
    UNROLL for (int hh = 0; hh < 2; ++hh) { const bf16x8 v = *(const bf16x8*)(yr + hh * 512 + e0); unpack8(v, y + hh * 8); }
    float ss = 0.f;
    UNROLL for (int i = 0; i < 16; ++i) ss += y[i] * y[i];
    ss = wave_sum(ss);
    const float rstd = rsqrtf(ss * (1.f / 1024.f) + EPSF);
    const float* g = mod + (size_t)(layer * 9 + mr) * 6144 + (MODE == 1 ? 2048 : 5120);
    const float* wp = (MODE == 1 ? p.n_mix_post : p.n_mlp_post) + layer * 1024;
    UNROLL for (int hh = 0; hh < 2; ++hh) UNROLL for (int e = 0; e < 8; ++e) {
      const int c = hh * 512 + e0 + e;
      x[hh * 8 + e] += g[c] * (y[hh * 8 + e] * rstd * wp[c]);
    }
  }
  UNROLL for (int hh = 0; hh < 2; ++hh) UNROLL for (int v4 = 0; v4 < 2; ++v4)
    *(float4*)(xr + hh * 512 + e0 + v4 * 4) = make_float4(x[hh * 8 + v4 * 4], x[hh * 8 + v4 * 4 + 1], x[hh * 8 + v4 * 4 + 2], x[hh * 8 + v4 * 4 + 3]);
  if (MODE == 2 && layer == 3) return;
  const int nl = MODE == 2 ? layer + 1 : layer;
  const float* wpre = (MODE == 1 ? p.n_mlp_pre : p.n_mix_pre) + nl * 1024;
  const float* m2 = mod + (size_t)(nl * 9 + mr) * 6144;
  const float* sh = m2 + (MODE == 1 ? 3072 : 0);
  const float* sc = m2 + (MODE == 1 ? 4096 : 1024);
  float ss = 0.f;
  UNROLL for (int i = 0; i < 16; ++i) ss += x[i] * x[i];
  ss = wave_sum(ss);
  const float rstd = rsqrtf(ss * (1.f / 1024.f) + EPSF);
  UNROLL for (int hh = 0; hh < 2; ++hh) {
    bf16x8 o;
    UNROLL for (int e = 0; e < 8; ++e) {
      const int c = hh * 512 + e0 + e;
      o[e] = (short)f2bf(x[hh * 8 + e] * rstd * wpre[c] * (1.f + sc[c]) + sh[c]);
    }
    const int col = hh * 512 + e0;
    *(bf16x8*)((bf*)(p.ws + OFF_H) + ((size_t)(col >> 5) * TALL + row) * 32 + (col & 31)) = o;
  }
}

template <int EPI>
DI void gemm_tile(char* smem, const bf* A0, const bf* A1, int lda, int ksplit, const bf* Bt, int K, int m0, int n0,
                  bf* C, int ldc, float* gates) {
  const int tid = tid_(), lane = tid & 63, w = tid >> 6, r = lane & 15, q = lane >> 4;
  const int wm = w >> 1, wn = w & 1;
  const int lr = tid >> 3, c8 = (tid & 7) * 8;
  bf16x8 ra[4], rb[4];
  f32x4 acc[4][4];
  UNROLL for (int i = 0; i < 4; ++i) UNROLL for (int jn = 0; jn < 4; ++jn) acc[i][jn] = f32x4{0.f, 0.f, 0.f, 0.f};
  const int nk = K >> 6;
  {
    const bf* Ab = A0;
    UNROLL for (int i = 0; i < 4; ++i) {
      ra[i] = *(const bf16x8*)(Ab + (size_t)(m0 + lr + 32 * i) * lda + c8);
      rb[i] = *(const bf16x8*)(Bt + (size_t)(n0 + lr + 32 * i) * K + c8);
    }
    bf* As = (bf*)smem; bf* Bs = As + 128 * 72;
    UNROLL for (int i = 0; i < 4; ++i) { *(bf16x8*)(As + (lr + 32 * i) * 72 + c8) = ra[i]; *(bf16x8*)(Bs + (lr + 32 * i) * 72 + c8) = rb[i]; }
  }
  __syncthreads();
  for (int kt = 0; kt < nk; ++kt) {
    if (kt + 1 < nk) {
      const int k0 = (kt + 1) << 6;
      const bf* Ab = (k0 < ksplit) ? A0 + k0 : A1 + (k0 - ksplit);
      UNROLL for (int i = 0; i < 4; ++i) {
        ra[i] = *(const bf16x8*)(Ab + (size_t)(m0 + lr + 32 * i) * lda + c8);
        rb[i] = *(const bf16x8*)(Bt + (size_t)(n0 + lr + 32 * i) * K + k0 + c8);
      }
    }
    const bf* As = (const bf*)smem + (kt & 1) * (2 * 128 * 72); const bf* Bs = As + 128 * 72;
    UNROLL for (int ks = 0; ks < 2; ++ks) {
      bf16x8 af[4], bfr[4];
      UNROLL for (int i = 0; i < 4; ++i) {
        af[i]  = *(const bf16x8*)(As + (wm * 64 + i * 16 + r) * 72 + ks * 32 + q * 8);
        bfr[i] = *(const bf16x8*)(Bs + (wn * 64 + i * 16 + r) * 72 + ks * 32 + q * 8);
      }
      UNROLL for (int mi = 0; mi < 4; ++mi) UNROLL for (int ni = 0; ni < 4; ++ni) acc[mi][ni] = MFMA16(bfr[ni], af[mi], acc[mi][ni]);
    }
    if (kt + 1 < nk) {
      bf* Aw = (bf*)smem + ((kt + 1) & 1) * (2 * 128 * 72); bf* Bw = Aw + 128 * 72;
      UNROLL for (int i = 0; i < 4; ++i) { *(bf16x8*)(Aw + (lr + 32 * i) * 72 + c8) = ra[i]; *(bf16x8*)(Bw + (lr + 32 * i) * 72 + c8) = rb[i]; }
    }
    __syncthreads();
  }
  UNROLL for (int mi = 0; mi < 4; ++mi) UNROLL for (int ni = 0; ni < 4; ++ni) {
    const int m = m0 + wm * 64 + mi * 16 + r, n = n0 + wn * 64 + ni * 16 + q * 4;
    f32x4 v = acc[mi][ni];
    if (EPI == 0) {
      if (n < 3072) *(s16x4*)(C + (size_t)m * ldc + n) = pack4(v);
      else if (n < 3088) *(float4*)(gates + (size_t)m * 16 + (n - 3072)) = make_float4(v[0], v[1], v[2], v[3]);
    } else if (EPI == 1) {
      *(s16x4*)(C + (size_t)m * ldc + n) = pack4(v);
    } else {
      UNROLL for (int e = 0; e < 4; ++e) { const float t = fmaxf(v[e], 0.f); v[e] = t * t; }
      *(s16x4*)(C + (size_t)m * ldc + n) = pack4(v);
    }
  }
}

DI unsigned xcc_id() { return (unsigned)__builtin_amdgcn_s_getreg((3 << 11) | 20) & 0xFu; }
#define WAIT_VM(n) asm volatile("s_waitcnt vmcnt(" #n ")" ::: "memory")
template <int EPI, int VAR = 0, int BLK = 0>
DI void gemm_tile2(char* smem, const bf* A0, const bf* A1, int lda, int ksplit, const bf* Bt, int K, int m0, int n0,
                   bf* C, int ldc, float* gates) {
  const int tid = tid_(), lane = tid & 63, w = tid >> 6, r = lane & 15, q = lane >> 4;
  const int wm = w >> 1, wn = w & 1;
  const int lrow = lane >> 2, lseg = (lane & 3) * 8;
  f32x4 acc[4][4];
  UNROLL for (int i = 0; i < 4; ++i) UNROLL for (int jn = 0; jn < 4; ++jn) acc[i][jn] = f32x4{0.f, 0.f, 0.f, 0.f};
  const int nk = K >> 5;
  const unsigned sbase = (unsigned)(size_t)smem;
#define GEMM2_ISSUE(kt_)                                                                                              \
  {                                                                                                                   \
    const int k0_ = (kt_) << 5;                                                                                       \
    const bf* Ab_ = (k0_ < ksplit) ? A0 + k0_ : A1 + (k0_ - ksplit);                                                  \
    char* sb_ = smem + ((kt_) & 3) * 16384;                                                                           \
    UNROLL for (int i_ = 0; i_ < 2; ++i_) {                                                                           \
      const int c_ = i_ * 4 + w;                                                                                      \
      const bf* ga_ = BLK ? A0 + ((size_t)(kt_) * TALL + m0 + c_ * 16 + lrow) * 32 + lseg                              \
                          : Ab_ + (size_t)(m0 + c_ * 16 + lrow) * lda + lseg;                                         \
      const bf* gb_ = BLK ? Bt + ((size_t)(kt_) * 1024 + n0 + c_ * 16 + lrow) * 32 + lseg                              \
                          : Bt + (size_t)(n0 + c_ * 16 + lrow) * K + k0_ + lseg;                                      \
      __builtin_amdgcn_global_load_lds((const unsigned*)ga_, (unsigned*)(sb_ + c_ * 1024), 16, 0, 0);                 \
      __builtin_amdgcn_global_load_lds((const unsigned*)gb_, (unsigned*)(sb_ + 8192 + c_ * 1024), 16, 0, 0);          \
    }                                                                                                                 \
  }
  if (VAR != 2) { GEMM2_ISSUE(0) GEMM2_ISSUE(1) GEMM2_ISSUE(2) }
  for (int kt = 0; kt < nk; ++kt) {
    const int rem = nk - 1 - kt;
    if (rem >= 2) WAIT_VM(8); else if (rem == 1) WAIT_VM(4); else WAIT_VM(0);
    asm volatile("s_waitcnt lgkmcnt(0)" ::: "memory");
    __builtin_amdgcn_s_barrier();
    if (VAR != 2) { if (kt + 3 < nk) GEMM2_ISSUE(kt + 3) }
    if (VAR == 3) continue;
    bf16x8 af[4], bfr[4];
    {
      const unsigned sa = sbase + (kt & 3) * 16384 + (wm * 64 + r) * 64 + q * 16;
      const unsigned sb = sbase + (kt & 3) * 16384 + 8192 + (wn * 64 + r) * 64 + q * 16;
      asm volatile(
          "ds_read_b128 %0, %8\n\tds_read_b128 %1, %8 offset:1024\n\tds_read_b128 %2, %8 offset:2048\n\tds_read_b128 %3, %8 offset:3072\n\t"
          "ds_read_b128 %4, %9\n\tds_read_b128 %5, %9 offset:1024\n\tds_read_b128 %6, %9 offset:2048\n\tds_read_b128 %7, %9 offset:3072\n\t"
          "s_waitcnt lgkmcnt(0)"
          : "=&v"(af[0]), "=&v"(af[1]), "=&v"(af[2]), "=&v"(af[3]), "=&v"(bfr[0]), "=&v"(bfr[1]), "=&v"(bfr[2]), "=&v"(bfr[3])
          : "v"(sa), "v"(sb)
          : "memory");
    }
    UNROLL for (int mi = 0; mi < 4; ++mi) UNROLL for (int ni = 0; ni < 4; ++ni) acc[mi][ni] = MFMA16(bfr[ni], af[mi], acc[mi][ni]);
  }
#undef GEMM2_ISSUE
  if (VAR != 0) {
    float t = 0.f;
    UNROLL for (int mi = 0; mi < 4; ++mi) UNROLL for (int ni = 0; ni < 4; ++ni) t += acc[mi][ni][0] + acc[mi][ni][1] + acc[mi][ni][2] + acc[mi][ni][3];
    if (t == 12345.678f) gates[tid] = t;
    return;
  }
  UNROLL for (int mi = 0; mi < 4; ++mi) UNROLL for (int ni = 0; ni < 4; ++ni) {
    const int m = m0 + wm * 64 + mi * 16 + r, n = n0 + wn * 64 + ni * 16 + q * 4;
    f32x4 v = acc[mi][ni];
    if (EPI == 0) {
      if (n < 3072) *(s16x4*)(C + (size_t)m * ldc + n) = pack4(v);
      else if (n < 3088) *(float4*)(gates + (size_t)m * 16 + (n - 3072)) = make_float4(v[0], v[1], v[2], v[3]);
    } else if (EPI == 1) {
      *(s16x4*)(C + (size_t)m * ldc + n) = pack4(v);
    } else {
      UNROLL for (int e = 0; e < 4; ++e) { const float t = fmaxf(v[e], 0.f); v[e] = t * t; }
      *(s16x4*)(C + (size_t)m * ldc + n) = pack4(v);
    }
  }
}

DI void gates_tile(const bf* H, const bf* Wb, int m0, float* gates) {
  const int tid = tid512_(), lane = tid & 63, w = tid >> 6, r = lane & 15, q = lane >> 4;
  f32x4 acc0 = f32x4{0.f, 0.f, 0.f, 0.f}, acc1 = f32x4{0.f, 0.f, 0.f, 0.f};
  const bf* a0p = H + (size_t)(m0 + w * 32 + r) * 32 + q * 8;
  const bf* a1p = a0p + 16 * 32;
  const bf* bp = Wb + (size_t)(3072 + r) * 32 + q * 8;
  _Pragma("unroll 4") for (int ks = 0; ks < 32; ++ks) {
    const bf16x8 b = *(const bf16x8*)(bp + (size_t)ks * 3200 * 32);
    acc0 = MFMA16(b, *(const bf16x8*)(a0p + (size_t)ks * TALL * 32), acc0);
    acc1 = MFMA16(b, *(const bf16x8*)(a1p + (size_t)ks * TALL * 32), acc1);
  }
  *(float4*)(gates + (size_t)(m0 + w * 32 + r) * 16 + q * 4) = make_float4(acc0[0], acc0[1], acc0[2], acc0[3]);
  *(float4*)(gates + (size_t)(m0 + w * 32 + 16 + r) * 16 + q * 4) = make_float4(acc1[0], acc1[1], acc1[2], acc1[3]);
}

template <int EPI>
DI void gemm_tile3(char* smem, const bf* A, const bf* Bt, int nrows, int K, int m0, int n0, bf* C, int ldc) {
  const int tid = tid_(), lane = tid & 63, w = tid >> 6, r = lane & 15, q = lane >> 4;
  const int wm = w >> 1, wn = w & 1;
  const int lrow = lane >> 2, lseg = (lane & 3) * 8;
  f32x4 acc[8][4];
  UNROLL for (int i = 0; i < 8; ++i) UNROLL for (int jn = 0; jn < 4; ++jn) acc[i][jn] = f32x4{0.f, 0.f, 0.f, 0.f};
  const int nk = K >> 5;
  const unsigned sbase = (unsigned)(size_t)smem;
#define GEMM3_ISSUE(kt_)                                                                                              \
  {                                                                                                                   \
    const int k0_ = (kt_) << 5;                                                                                       \
    char* sb_ = smem + ((kt_) % 3) * 24576;                                                                           \
    UNROLL for (int i_ = 0; i_ < 4; ++i_) {                                                                           \
      const int c_ = i_ * 4 + w;                                                                                      \
      __builtin_amdgcn_global_load_lds((const unsigned*)(A + ((size_t)(kt_) * TALL + m0 + c_ * 16 + lrow) * 32 + lseg),    \
                                       (unsigned*)(sb_ + c_ * 1024), 16, 0, 0);                                       \
    }                                                                                                                 \
    UNROLL for (int i_ = 0; i_ < 2; ++i_) {                                                                           \
      const int c_ = i_ * 4 + w;                                                                                      \
      __builtin_amdgcn_global_load_lds((const unsigned*)(Bt + ((size_t)(kt_) * nrows + n0 + c_ * 16 + lrow) * 32 + lseg),  \
                                       (unsigned*)(sb_ + 16384 + c_ * 1024), 16, 0, 0);                               \
    }                                                                                                                 \
  }
  GEMM3_ISSUE(0) GEMM3_ISSUE(1)
  int slot = 0;
  for (int kt = 0; kt < nk; ++kt) {
    if (kt + 1 < nk) WAIT_VM(6); else WAIT_VM(0);
    asm volatile("s_waitcnt lgkmcnt(0)" ::: "memory");
    __builtin_amdgcn_s_barrier();
    if (kt + 2 < nk) GEMM3_ISSUE(kt + 2)
    bf16x8 af[8], bfr[4];
    {
      const unsigned sa = sbase + slot * 24576 + (wm * 128 + r) * 64 + q * 16;
      const unsigned sb = sbase + slot * 24576 + 16384 + (wn * 64 + r) * 64 + q * 16;
      asm volatile(
          "ds_read_b128 %0, %13\n\tds_read_b128 %1, %13 offset:1024\n\tds_read_b128 %2, %13 offset:2048\n\tds_read_b128 %3, %13 offset:3072\n\t"
          "ds_read_b128 %4, %12\n\tds_read_b128 %5, %12 offset:1024\n\tds_read_b128 %6, %12 offset:2048\n\tds_read_b128 %7, %12 offset:3072\n\t"
          "ds_read_b128 %8, %12 offset:4096\n\tds_read_b128 %9, %12 offset:5120\n\tds_read_b128 %10, %12 offset:6144\n\tds_read_b128 %11, %12 offset:7168\n\t"
          "s_waitcnt lgkmcnt(4)"
          : "=&v"(bfr[0]), "=&v"(bfr[1]), "=&v"(bfr[2]), "=&v"(bfr[3]), "=&v"(af[0]), "=&v"(af[1]), "=&v"(af[2]), "=&v"(af[3]),
            "=&v"(af[4]), "=&v"(af[5]), "=&v"(af[6]), "=&v"(af[7])
          : "v"(sa), "v"(sb)
          : "memory");
    }
    UNROLL for (int mi = 0; mi < 4; ++mi) UNROLL for (int ni = 0; ni < 4; ++ni) acc[mi][ni] = MFMA16(bfr[ni], af[mi], acc[mi][ni]);
    asm volatile("s_waitcnt lgkmcnt(0)" : "+v"(af[4]), "+v"(af[5]), "+v"(af[6]), "+v"(af[7]) : : "memory");
    UNROLL for (int mi = 4; mi < 8; ++mi) UNROLL for (int ni = 0; ni < 4; ++ni) acc[mi][ni] = MFMA16(bfr[ni], af[mi], acc[mi][ni]);
    slot = slot == 2 ? 0 : slot + 1;
  }
#undef GEMM3_ISSUE
  UNROLL for (int mi = 0; mi < 8; ++mi) UNROLL for (int ni = 0; ni < 4; ++ni) {
    const int m = m0 + wm * 128 + mi * 16 + r, n = n0 + wn * 64 + ni * 16 + q * 4;
    f32x4 v = acc[mi][ni];
    if (EPI == 2) {
      UNROLL for (int e = 0; e < 4; ++e) { const float t = fmaxf(v[e], 0.f); v[e] = t * t; }
      *(s16x4*)(C + ((size_t)(n >> 5) * TALL + m) * 32 + (n & 31)) = pack4(v);
    } else {
      *(s16x4*)(C + (size_t)m * ldc + n) = pack4(v);
    }
  }
}

#define LDS_RD(D, ADDR, OFF) asm volatile("ds_read_b128 %0, %1 offset:" #OFF : "=v"(D) : "v"(ADDR) : "memory")
template <int BN, int EPI, int AMODE, int BMODE, int VAR = 0>
DI void gemm512(char* smem, const bf* A0, const bf* A1, int lda, int ksplit, const bf* Bt, int nrows, int K, int m0, int n0, bf* C, int ldc) {
  constexpr int MI = BN == 256 ? 8 : 4;
  constexpr int STAGE = BN == 256 ? 32768 : 24576;
  constexpr int NSLOT = BN == 256 ? 4 : 6;
  constexpr int PER = BN == 256 ? 4 : 3;
  const int tid = tid512_(), lane = tid & 63, w = tid >> 6, r = lane & 15, q = lane >> 4;
  const int wm = BN == 256 ? (w >> 2) : (w >> 1), wn = BN == 256 ? (w & 3) : (w & 1);
  const int lrow = lane >> 2, lseg = ((lane & 3) ^ ((0x78 >> (2 * (lane >> 4))) & 3)) * 8;
  f32x4 acc[MI][4];
  UNROLL for (int i = 0; i < MI; ++i) UNROLL for (int jn = 0; jn < 4; ++jn) acc[i][jn] = f32x4{0.f, 0.f, 0.f, 0.f};
  const int nk = K >> 5;
  const unsigned sbase = (unsigned)(size_t)smem;
  const unsigned rsw = (unsigned)((q ^ ((0x78 >> (2 * (r >> 2))) & 3)) * 16);
  const unsigned offa = (wm * (MI * 16) + r) * 64 + rsw, offb = 16384 + (wn * 64 + r) * 64 + rsw;
#define G5_ISSUE(kt_, slot_)                                                                                          \
  {                                                                                                                   \
    const int k0_ = (kt_) << 5;                                                                                       \
    char* sb_ = smem + (slot_) * STAGE;                                                                               \
    const bf* Ab_ = (k0_ < ksplit) ? A0 + k0_ : A1 + (k0_ - ksplit);                                                  \
    UNROLL for (int i_ = 0; i_ < 2; ++i_) {                                                                           \
      const int c_ = i_ * 8 + w;                                                                                      \
      const bf* ga_ = AMODE ? A0 + ((size_t)(kt_) * TALL + m0 + c_ * 16 + lrow) * 32 + lseg                            \
                            : Ab_ + (size_t)(m0 + c_ * 16 + lrow) * lda + lseg;                                       \
      __builtin_amdgcn_global_load_lds((const unsigned*)ga_, (unsigned*)(sb_ + c_ * 1024), 16, 0, 0);                 \
    }                                                                                                                 \
    UNROLL for (int i_ = 0; i_ < BN / 128; ++i_) {                                                                    \
      const int c_ = i_ * 8 + w;                                                                                      \
      const bf* gb_ = BMODE ? Bt + ((size_t)(kt_) * nrows + n0 + c_ * 16 + lrow) * 32 + lseg                           \
                            : Bt + (size_t)(n0 + c_ * 16 + lrow) * K + k0_ + lseg;                                    \
      __builtin_amdgcn_global_load_lds((const unsigned*)gb_, (unsigned*)(sb_ + 16384 + c_ * 1024), 16, 0, 0);         \
    }                                                                                                                 \
  }
#define G5_WAIT_TILES(n_)                                                                                             \
  {                                                                                                                   \
    const int nt_ = (n_);                                                                                             \
    if (PER == 4) { if (nt_ >= 3) WAIT_VM(12); else if (nt_ == 2) WAIT_VM(8); else if (nt_ == 1) WAIT_VM(4); else WAIT_VM(0); } \
    else { if (nt_ >= 5) WAIT_VM(15); else if (nt_ == 4) WAIT_VM(12); else if (nt_ == 3) WAIT_VM(9); else if (nt_ == 2) WAIT_VM(6); \
           else if (nt_ == 1) WAIT_VM(3); else WAIT_VM(0); }                                                          \
  }
  constexpr int AH = MI / 2;
  bf16x8 bc[4], bn[4], ax[AH], ay[AH];
  if (VAR != 2) { UNROLL for (int s = 0; s < NSLOT; ++s) G5_ISSUE(s, s) }
  G5_WAIT_TILES(NSLOT - 1)
  __builtin_amdgcn_s_barrier();
#define G5_RD_LO(BB, AA, SA, SB)                                                                                      \
  {                                                                                                                   \
    LDS_RD(BB[0], SB, 0); LDS_RD(BB[1], SB, 1024); LDS_RD(BB[2], SB, 2048); LDS_RD(BB[3], SB, 3072);                  \
    LDS_RD(AA[0], SA, 0); LDS_RD(AA[1], SA, 1024);                                                                    \
    if constexpr (AH == 4) { LDS_RD(AA[AH - 2], SA, 2048); LDS_RD(AA[AH - 1], SA, 3072); }                            \
  }
#define G5_RD_HI(AA, SA)                                                                                              \
  {                                                                                                                   \
    if constexpr (AH == 4) { LDS_RD(AA[0], SA, 4096); LDS_RD(AA[1], SA, 5120); LDS_RD(AA[AH - 2], SA, 6144); LDS_RD(AA[AH - 1], SA, 7168); } \
    else { LDS_RD(AA[0], SA, 2048); LDS_RD(AA[1], SA, 3072); }                                                        \
  }
#define G5_LGKM0_A(AA)                                                                                                \
  {                                                                                                                   \
    if constexpr (AH == 4) asm volatile("s_waitcnt lgkmcnt(0)" : "+v"(AA[0]), "+v"(AA[1]), "+v"(AA[2]), "+v"(AA[3]) : : "memory"); \
    else asm volatile("s_waitcnt lgkmcnt(0)" : "+v"(AA[0]), "+v"(AA[1]) : : "memory");                                \
  }
#define G5_LGKM0_BA(BB, AA)                                                                                           \
  {                                                                                                                   \
    if constexpr (AH == 4) asm volatile("s_waitcnt lgkmcnt(0)" : "+v"(BB[0]), "+v"(BB[1]), "+v"(BB[2]), "+v"(BB[3]), "+v"(AA[0]), "+v"(AA[1]), "+v"(AA[2]), "+v"(AA[3]) : : "memory"); \
    else asm volatile("s_waitcnt lgkmcnt(0)" : "+v"(BB[0]), "+v"(BB[1]), "+v"(BB[2]), "+v"(BB[3]), "+v"(AA[0]), "+v"(AA[1]) : : "memory"); \
  }
  {
    const unsigned sa = sbase + offa, sb = sbase + offb;
    G5_RD_LO(bc, ax, sa, sb)
    G5_LGKM0_BA(bc, ax)
  }
  int cslot = 0;
#define G5_STEP(BC, BN_)                                                                                              \
  {                                                                                                                   \
    {                                                                                                                 \
      const unsigned sa = sbase + cslot * STAGE + offa;                                                               \
      G5_RD_HI(ay, sa)                                                                                                \
    }                                                                                                                 \
    if (VAR != 3) { UNROLL for (int mi = 0; mi < AH; ++mi) UNROLL for (int ni = 0; ni < 4; ++ni) acc[mi][ni] = MFMA16(BC[ni], ax[mi], acc[mi][ni]); } \
    G5_LGKM0_A(ay)                                                                                                    \
    if (kt + 1 < nk) { const int t_ = nk - 2 - kt; G5_WAIT_TILES(t_ < NSLOT - 2 ? t_ : NSLOT - 2) }                   \
    __builtin_amdgcn_s_barrier();                                                                                     \
    if (VAR != 2) { if (kt + NSLOT < nk) G5_ISSUE(kt + NSLOT, cslot) }                                                \
    cslot = cslot == NSLOT - 1 ? 0 : cslot + 1;                                                                       \
    if (kt + 1 < nk) {                                                                                                \
      const unsigned sa = sbase + cslot * STAGE + offa, sb = sbase + cslot * STAGE + offb;                            \
      G5_RD_LO(BN_, ax, sa, sb)                                                                                       \
    }                                                                                                                 \
    if (VAR != 3) { UNROLL for (int mi = 0; mi < AH; ++mi) UNROLL for (int ni = 0; ni < 4; ++ni) acc[AH + mi][ni] = MFMA16(BC[ni], ay[mi], acc[AH + mi][ni]); } \
    G5_LGKM0_BA(BN_, ax)                                                                                              \
    ++kt;                                                                                                             \
  }
  for (int kt = 0; kt < nk;) {
    G5_STEP(bc, bn)
    G5_STEP(bn, bc)
  }
#undef G5_STEP
#undef G5_RD_LO
#undef G5_RD_HI
#undef G5_LGKM0_A
#undef G5_LGKM0_BA
#undef G5_ISSUE
#undef G5_WAIT_TILES
  if (VAR != 0) {
    float t = 0.f;
    UNROLL for (int mi = 0; mi < MI; ++mi) UNROLL for (int ni = 0; ni < 4; ++ni) t += acc[mi][ni][0] + acc[mi][ni][1] + acc[mi][ni][2] + acc[mi][ni][3];
    if (t == 12345.678f) C[tid] = (bf)1;
    return;
  }
  UNROLL for (int mi = 0; mi < MI; ++mi) UNROLL for (int ni = 0; ni < 4; ++ni) {
    const int m = m0 + wm * (MI * 16) + mi * 16 + r, n = n0 + wn * 64 + ni * 16 + q * 4;
    f32x4 v = acc[mi][ni];
    if (EPI == 2) {
      UNROLL for (int e = 0; e < 4; ++e) { const float t = fmaxf(v[e], 0.f); v[e] = t * t; }
      *(s16x4*)(C + ((size_t)(n >> 5) * TALL + m) * 32 + (n & 31)) = pack4(v);
    } else {
      *(s16x4*)(C + (size_t)m * ldc + n) = pack4(v);
    }
  }
}

DI void conv_item(const Params& p, int layer, int item) {
  const bool even = !(layer & 1); const int j = layer >> 1;
  const int tid = tid_(), lane = tid & 63, w = tid >> 6;
  const bf* P = (const bf*)(p.ws + OFF_P);
  bf* X = (bf*)(p.ws + OFF_RX);
  for (int tt = 0; tt < 4; ++tt) {
    const int tok = item * 16 + w * 4 + tt;
    int L, pos;
    if (tok < TCTX) { L = 256; pos = tok & 255; } else { L = 4096; pos = (tok - TCTX) & 4095; }
    const bool hp = pos > 0, hn = pos < L - 1;
    const bf* pr = P + (size_t)tok * PLD;
    if (even) {
      const float* cw = p.gdn_conv + (size_t)j * 3 * 1536;
      for (int g = 0; g < 12; ++g) {
        const int c = g * 128 + lane * 2;
        const unsigned ua = hp ? *(const unsigned*)(pr - PLD + c) : 0u;
        const unsigned ub = *(const unsigned*)(pr + c);
        const unsigned uc = hn ? *(const unsigned*)(pr + PLD + c) : 0u;
        const float2 w0 = *(const float2*)(cw + c), w1 = *(const float2*)(cw + 1536 + c), w2 = *(const float2*)(cw + 3072 + c);
        float v0 = bflo(ua) * w0.x + bflo(ub) * w1.x + bflo(uc) * w2.x;
        float v1 = bfhi(ua) * w0.y + bfhi(ub) * w1.y + bfhi(uc) * w2.y;
        v0 = silu(v0); v1 = silu(v1);
        if (g < 8) {
          const float ss = wave_sum(v0 * v0 + v1 * v1);
          float sc = rsqrtf(ss + EPSF);
          if (g < 4) sc *= 0.08838834764831845f;
          v0 *= sc; v1 *= sc;
        }
        *(unsigned*)(X + (size_t)tok * 1536 + c) = packbf(v0, v1);
      }
    } else {
      const float* cw = p.ssd_conv + (size_t)j * 3 * 1024;
      const float* cb = p.ssd_conv_b + (size_t)j * 1024;
      for (int g = 0; g < 8; ++g) {
        const int c = g * 128 + lane * 2;
        const unsigned ua = hp ? *(const unsigned*)(pr - PLD + 512 + c) : 0u;
        const unsigned ub = *(const unsigned*)(pr + 512 + c);
        const unsigned uc = hn ? *(const unsigned*)(pr + PLD + 512 + c) : 0u;
        const float2 w0 = *(const float2*)(cw + c), w1 = *(const float2*)(cw + 1024 + c), w2 = *(const float2*)(cw + 2048 + c);
        const float2 bb = *(const float2*)(cb + c);
        float v0 = bflo(ua) * w0.x + bflo(ub) * w1.x + bflo(uc) * w2.x + bb.x;
        float v1 = bfhi(ua) * w0.y + bfhi(ub) * w1.y + bfhi(uc) * w2.y + bb.y;
        *(unsigned*)(X + (size_t)tok * 1024 + c) = packbf(silu(v0), silu(v1));
      }
    }
  }
  {
    const int tok = item * 16 + (tid >> 4), gi = tid & 15;
    const float gv = ((const float*)(p.ws + OFF_GATES))[(size_t)tok * 16 + gi];
    float o;
    if (even) {
      if (gi < 8) o = 1.f / (1.f + expf(-gv));
      else o = -expf(p.gdn_alog[j * 8 + gi - 8]) * softplus(gv + p.gdn_dtb[j * 8 + gi - 8]);
    } else {
      o = softplus(gv + p.ssd_dtb[j * 16 + gi]);
    }
    ((float*)(p.ws + OFF_BG))[(size_t)tok * 16 + gi] = o;
  }
}

DI void kvprep_item(char* smem, const Params& p, int layer, int item) {
  const bool even = !(layer & 1); const int j = layer >> 1; const int nH = even ? 2 : 4;
  const int tid = tid_();
  const int nctx = 16 * nH * 4;
  const bool ctx = item < nctx;
  int seq, kvh, tile, S;
  if (ctx) { seq = item / (nH * 4); kvh = (item >> 2) % nH; tile = item & 3; S = 256; }
  else { const int it = item - nctx; seq = it / (nH * 72); kvh = (it / 72) % nH; tile = it % 72; S = 4608; }
  const size_t slot = ctx ? (size_t)(seq * nH + kvh) * 256 * 128 : (size_t)16 * nH * 256 * 128 + (size_t)(seq * nH + kvh) * 4608 * 128;
  bf* Kd = (bf*)(p.ws + OFF_KB) + slot;
  bf* Vd = (bf*)(p.ws + OFF_VT) + slot;
  const int r = tid >> 2, pp = tid & 3;
  const int key = tile * 64 + r;
  const bool fromP = ctx || tile < 64;
  float kx[32], vx[32];
  if (fromP) {
    const int tok = ctx ? seq * 256 + key : TCTX + seq * 4096 + key;
    const bf* pr = (const bf*)(p.ws + OFF_P) + (size_t)tok * PLD;
    const int kcol = (even ? 2560 : 2048) + kvh * 128, vcol = (even ? 2816 : 2560) + kvh * 128;
    UNROLL for (int m = 0; m < 4; ++m) {
      unpack8(*(const bf16x8*)(pr + kcol + pp * 8 + 32 * m), kx + m * 8);
      unpack8(*(const bf16x8*)(pr + vcol + pp * 8 + 32 * m), vx + m * 8);
    }
  } else {
    const int ck = key - 4096;
    const float* ksrc = (even ? p.cgk : p.cnk) + ((size_t)((seq * 2 + j) * 512 + ck) * nH + kvh) * 128;
    const float* vsrc = (even ? p.cgv : p.cnv) + ((size_t)((seq * 2 + j) * 512 + ck) * nH + kvh) * 128;
    UNROLL for (int m = 0; m < 4; ++m) UNROLL for (int v4 = 0; v4 < 2; ++v4) {
      const float4 a = *(const float4*)(ksrc + pp * 8 + 32 * m + v4 * 4);
      const float4 b = *(const float4*)(vsrc + pp * 8 + 32 * m + v4 * 4);
      kx[m * 8 + v4 * 4] = a.x; kx[m * 8 + v4 * 4 + 1] = a.y; kx[m * 8 + v4 * 4 + 2] = a.z; kx[m * 8 + v4 * 4 + 3] = a.w;
      vx[m * 8 + v4 * 4] = b.x; vx[m * 8 + v4 * 4 + 1] = b.y; vx[m * 8 + v4 * 4 + 2] = b.z; vx[m * 8 + v4 * 4 + 3] = b.w;
    }
  }
  if (even && fromP) {
    float ss = 0.f;
    UNROLL for (int i = 0; i < 32; ++i) ss += kx[i] * kx[i];
    ss += __shfl_xor(ss, 1); ss += __shfl_xor(ss, 2);
    const float rstd = rsqrtf(ss * (1.f / 128.f) + EPSF);
    const float* kn = p.k_norm + j * 128;
    UNROLL for (int m = 0; m < 4; ++m) UNROLL for (int e = 0; e < 8; ++e) kx[m * 8 + e] *= rstd * kn[pp * 8 + 32 * m + e];
  }
  if (ctx) {
    float* ko = p.out + (even ? OUT_GK : OUT_NK) + ((size_t)((seq * 2 + j) * 256 + key) * nH + kvh) * 128;
    float* vo = p.out + (even ? OUT_GV : OUT_NV) + ((size_t)((seq * 2 + j) * 256 + key) * nH + kvh) * 128;
    UNROLL for (int m = 0; m < 4; ++m) UNROLL for (int v4 = 0; v4 < 2; ++v4) {
      *(float4*)(ko + pp * 8 + 32 * m + v4 * 4) = make_float4(kx[m * 8 + v4 * 4], kx[m * 8 + v4 * 4 + 1], kx[m * 8 + v4 * 4 + 2], kx[m * 8 + v4 * 4 + 3]);
      *(float4*)(vo + pp * 8 + 32 * m + v4 * 4) = make_float4(vx[m * 8 + v4 * 4], vx[m * 8 + v4 * 4 + 1], vx[m * 8 + v4 * 4 + 2], vx[m * 8 + v4 * 4 + 3]);
    }
  } else if (even && fromP) {
    const float* tab = (const float*)(p.ws + OFF_ROPE);
    const int prow = key >> 6, pcol = key & 63;
    UNROLL for (int e = 0; e < 8; ++e) {
      const int f = pp * 8 + e;
      float c = tab[prow * 32 + f], s = tab[2048 + prow * 32 + f];
      float x1 = kx[e], x2 = kx[8 + e];
      kx[e] = x1 * c - x2 * s; kx[8 + e] = x2 * c + x1 * s;
      c = tab[pcol * 32 + f]; s = tab[2048 + pcol * 32 + f];
      x1 = kx[16 + e]; x2 = kx[24 + e];
      kx[16 + e] = x1 * c - x2 * s; kx[24 + e] = x2 * c + x1 * s;
    }
  }
  bf* vt = (bf*)smem;
  UNROLL for (int m = 0; m < 4; ++m) {
    bf16x8 ko, vv;
    UNROLL for (int e = 0; e < 8; ++e) { ko[e] = (short)f2bf(kx[m * 8 + e]); vv[e] = (short)f2bf(vx[m * 8 + e]); }
    *(bf16x8*)(Kd + (size_t)key * 128 + pp * 8 + 32 * m) = ko;
    *(bf16x8*)(vt + r * 136 + pp * 8 + 32 * m) = vv;
  }
  __syncthreads();
  {
    const int d = tid >> 1, half = tid & 1;
    UNROLL for (int i = 0; i < 4; ++i) {
      bf16x8 o;
      UNROLL for (int e = 0; e < 8; ++e) o[e] = (short)vt[(half * 32 + i * 8 + e) * 136 + d];
      *(bf16x8*)(Vd + (size_t)d * S + tile * 64 + half * 32 + i * 8) = o;
    }
  }
}

DI void qprep_item(const Params& p, int layer, int item) {
  const int j = layer >> 1, tid = tid_();
  const int tile = item >> 2, h = item & 3;
  const int r = tid >> 2, pp = tid & 3;
  const int tok = tile * 64 + r;
  bf* pr = (bf*)(p.ws + OFF_P) + (size_t)tok * PLD + 2048 + h * 128;
  float qx[32];
  UNROLL for (int m = 0; m < 4; ++m) unpack8(*(const bf16x8*)(pr + pp * 8 + 32 * m), qx + m * 8);
  float ss = 0.f;
  UNROLL for (int i = 0; i < 32; ++i) ss += qx[i] * qx[i];
  ss += __shfl_xor(ss, 1); ss += __shfl_xor(ss, 2);
  const float rstd = rsqrtf(ss * (1.f / 128.f) + EPSF);
  const float* qn = p.q_norm + j * 128;
  UNROLL for (int m = 0; m < 4; ++m) UNROLL for (int e = 0; e < 8; ++e) qx[m * 8 + e] *= rstd * qn[pp * 8 + 32 * m + e];
  if (tok >= TCTX) {
    const float* tab = (const float*)(p.ws + OFF_ROPE);
    const int pos = (tok - TCTX) & 4095, prow = pos >> 6, pcol = pos & 63;
    UNROLL for (int e = 0; e < 8; ++e) {
      const int f = pp * 8 + e;
      float c = tab[prow * 32 + f], s = tab[2048 + prow * 32 + f];
      float x1 = qx[e], x2 = qx[8 + e];
      qx[e] = x1 * c - x2 * s; qx[8 + e] = x2 * c + x1 * s;
      c = tab[pcol * 32 + f]; s = tab[2048 + pcol * 32 + f];
      x1 = qx[16 + e]; x2 = qx[24 + e];
      qx[16 + e] = x1 * c - x2 * s; qx[24 + e] = x2 * c + x1 * s;
    }
  }
  UNROLL for (int m = 0; m < 4; ++m) {
    bf16x8 o;
    UNROLL for (int e = 0; e < 8; ++e) o[e] = (short)f2bf(qx[m * 8 + e]);
    *(bf16x8*)(pr + pp * 8 + 32 * m) = o;
  }
}

template <int QT, int MODE>
DI void attn_tile(char* smem, bf* Q, int ooff, const bf* Kb, const bf* Vt, int S, int ntiles, int r0, int qrow, const float* rpb) {
  const int tid = tid_(), lane = tid & 63, w = tid >> 6, r = lane & 15, q = lane >> 4;
  const float LOG2E = 1.4426950408889634f;
  int* hbar = (int*)(smem + SMEM_BYTES - 16); int hgen = 0;
  const unsigned sbase = (unsigned)(size_t)smem;
  if (tid == 0) *hbar = 0;
  const float cs = 0.08838834764831845f * LOG2E;
  bf16x8 qf[QT][4];
  UNROLL for (int qt = 0; qt < QT; ++qt) UNROLL for (int ks = 0; ks < 4; ++ks)
    qf[qt][ks] = *(const bf16x8*)(Q + (size_t)(w * 16 * QT + qt * 16 + r) * PLD + ks * 32 + q * 8);
  f32x4 o[8][QT];
  float mrow[QT], lrow[QT];
  UNROLL for (int qt = 0; qt < QT; ++qt) { mrow[qt] = -INFINITY; lrow[qt] = 0.f; UNROLL for (int dt = 0; dt < 8; ++dt) o[dt][qt] = f32x4{0.f, 0.f, 0.f, 0.f}; }
  const int krow = tid >> 2, kseg = tid & 3, vrow = tid >> 1, vhalf = tid & 1;
  bf16x8 kr_[4], vr_[4];
  {
    const int ko = MODE == 1 ? r0 * 64 : 0;
    UNROLL for (int i = 0; i < 4; ++i) {
      kr_[i] = *(const bf16x8*)(Kb + (size_t)(ko + krow) * 128 + kseg * 32 + i * 8);
      vr_[i] = *(const bf16x8*)(Vt + (size_t)vrow * S + ko + vhalf * 32 + i * 8);
    }
    bf* Ks = (bf*)smem; bf* Vs = Ks + 64 * 136;
    UNROLL for (int i = 0; i < 4; ++i) { *(bf16x8*)(Ks + krow * 136 + kseg * 32 + i * 8) = kr_[i]; *(bf16x8*)(Vs + vrow * 72 + vhalf * 32 + i * 8) = vr_[i]; }
  }
  __syncthreads();
  for (int it = 0; it < ntiles; ++it) {
    if (it + 1 < ntiles) {
      const int nx = it + 1;
      const int ko = MODE == 1 ? (nx < 8 ? (r0 + nx) * 64 : 4096 + (nx - 8) * 64) : nx * 64;
      UNROLL for (int i = 0; i < 4; ++i) {
        kr_[i] = *(const bf16x8*)(Kb + (size_t)(ko + krow) * 128 + kseg * 32 + i * 8);
        vr_[i] = *(const bf16x8*)(Vt + (size_t)vrow * S + ko + vhalf * 32 + i * 8);
      }
    }
    const bf* Ks = (const bf*)smem + (it & 1) * 17920; const bf* Vs = Ks + 64 * 136;
    f32x4 s[4][QT];
    {
      const unsigned kad = sbase + (it & 1) * 35840 + r * 272 + q * 16;
      bf16x8 ka0[4], ka1[4];
#define AT_RDK(KA, O0, O1, O2, O3) { LDS_RD(KA[0], kad, O0); LDS_RD(KA[1], kad, O1); LDS_RD(KA[2], kad, O2); LDS_RD(KA[3], kad, O3); }
#define AT_WAITK(N, KA) asm volatile("s_waitcnt lgkmcnt(" #N ")" : "+v"(KA[0]), "+v"(KA[1]), "+v"(KA[2]), "+v"(KA[3]) : : "memory")
#define AT_MMK(KT, KA)                                                                        \
      UNROLL for (int qt = 0; qt < QT; ++qt) {                                                \
        f32x4 a_ = f32x4{0.f, 0.f, 0.f, 0.f};                                                 \
        UNROLL for (int ks = 0; ks < 4; ++ks) a_ = MFMA16(KA[ks], qf[qt][ks], a_);            \
        s[KT][qt] = a_;                                                                       \
      }
      AT_RDK(ka0, 0, 64, 128, 192)
      AT_RDK(ka1, 4352, 4416, 4480, 4544)
      AT_WAITK(4, ka0);
      AT_MMK(0, ka0)
      AT_RDK(ka0, 8704, 8768, 8832, 8896)
      AT_WAITK(4, ka1);
      AT_MMK(1, ka1)
      AT_RDK(ka1, 13056, 13120, 13184, 13248)
      AT_WAITK(4, ka0);
      AT_MMK(2, ka0)
      AT_WAITK(0, ka1);
      AT_MMK(3, ka1)
#undef AT_RDK
#undef AT_WAITK
#undef AT_MMK
    }
    UNROLL for (int qt = 0; qt < QT; ++qt) {
      float mn, alpha, ls = 0.f;
      if (MODE == 1 && it < 8) {
        UNROLL for (int kt = 0; kt < 4; ++kt) UNROLL for (int jj = 0; jj < 4; ++jj) {
          const int qc = w * 16 + r, kc = kt * 16 + q * 4 + jj;
          int c0 = qc - 8; c0 = c0 < 0 ? 0 : (c0 > 48 ? 48 : c0);
          const bool valid = kc >= c0 && kc < c0 + 16;
          const int ro = r0 + it - qrow + 7; int co = kc - qc + 15; co = co < 0 ? 0 : (co > 30 ? 30 : co);
          s[kt][qt][jj] = valid ? s[kt][qt][jj] * cs + rpb[ro * 31 + co] * LOG2E : -INFINITY;
        }
        float mx = -INFINITY;
        UNROLL for (int kt = 0; kt < 4; ++kt) UNROLL for (int jj = 0; jj < 4; ++jj) mx = fmaxf(mx, s[kt][qt][jj]);
        mx = fmaxf(mx, __shfl_xor(mx, 16)); mx = fmaxf(mx, __shfl_xor(mx, 32));
        mn = fmaxf(mrow[qt], mx);
        alpha = __builtin_amdgcn_exp2f(mrow[qt] - mn);
        UNROLL for (int kt = 0; kt < 4; ++kt) UNROLL for (int jj = 0; jj < 4; ++jj) { const float pv = __builtin_amdgcn_exp2f(s[kt][qt][jj] - mn); s[kt][qt][jj] = pv; ls += pv; }
      } else {
        float mx = -INFINITY;
        UNROLL for (int kt = 0; kt < 4; ++kt) UNROLL for (int jj = 0; jj < 4; ++jj) mx = fmaxf(mx, s[kt][qt][jj]);
        mx = fmaxf(mx, __shfl_xor(mx, 16)); mx = fmaxf(mx, __shfl_xor(mx, 32));
        mn = fmaxf(mrow[qt], mx * cs);
        alpha = __builtin_amdgcn_exp2f(mrow[qt] - mn);
        UNROLL for (int kt = 0; kt < 4; ++kt) UNROLL for (int jj = 0; jj < 4; ++jj) { const float pv = __builtin_amdgcn_exp2f(fmaf(s[kt][qt][jj], cs, -mn)); s[kt][qt][jj] = pv; ls += pv; }
      }
      mrow[qt] = mn;
      lrow[qt] = lrow[qt] * alpha + ls;
      if (__any(alpha != 1.f)) { UNROLL for (int dt = 0; dt < 8; ++dt) o[dt][qt] *= alpha; }
    }
    bf16x8 pf[2][QT];
    UNROLL for (int g = 0; g < 2; ++g) UNROLL for (int qt = 0; qt < QT; ++qt) pf[g][qt] = cat8(pack4(s[2 * g][qt]), pack4(s[2 * g + 1][qt]));
    {
      const unsigned vad = sbase + (it & 1) * 35840 + 17408 + r * 144 + q * 8;
      bf16x8 vf[4];
#define AT_RDV(F, SLOT)                                                                                         \
      {                                                                                                         \
        const unsigned ad_ = vad + ((F) >> 1) * 2304;                                                           \
        if (((F) & 1) == 0) asm volatile("ds_read2_b64 %0, %1 offset1:4" : "=v"(vf[SLOT]) : "v"(ad_) : "memory");          \
        else asm volatile("ds_read2_b64 %0, %1 offset0:8 offset1:12" : "=v"(vf[SLOT]) : "v"(ad_) : "memory");   \
      }
#define AT_WAITV(N, SLOT) asm volatile("s_waitcnt lgkmcnt(" #N ")" : "+v"(vf[SLOT]) : : "memory")
      AT_RDV(0, 0) AT_RDV(1, 1) AT_RDV(2, 2) AT_RDV(3, 3)
      UNROLL for (int f = 0; f < 16; ++f) {
        const int dt = f >> 1, g = f & 1, sl = f & 3;
        if (f < 13) { AT_WAITV(3, sl); } else if (f == 13) { AT_WAITV(2, sl); } else if (f == 14) { AT_WAITV(1, sl); } else { AT_WAITV(0, sl); }
        UNROLL for (int qt = 0; qt < QT; ++qt) o[dt][qt] = MFMA16(vf[sl], pf[g][qt], o[dt][qt]);
        if (f + 4 < 16) AT_RDV(f + 4, sl)
      }
#undef AT_RDV
#undef AT_WAITV
    }
    if (it + 1 < ntiles) {
      bf* Kw = (bf*)smem + ((it + 1) & 1) * 17920; bf* Vw = Kw + 64 * 136;
      UNROLL for (int i = 0; i < 4; ++i) { *(bf16x8*)(Kw + krow * 136 + kseg * 32 + i * 8) = kr_[i]; *(bf16x8*)(Vw + vrow * 72 + vhalf * 32 + i * 8) = vr_[i]; }
    }
    half_barrier(hbar, hgen, lane);
  }
  UNROLL for (int qt = 0; qt < QT; ++qt) {
    float l = lrow[qt];
    l += __shfl_xor(l, 16); l += __shfl_xor(l, 32);
    const float inv = 1.f / l;
    UNROLL for (int dt = 0; dt < 8; ++dt) {
      f32x4 v = o[dt][qt]; v *= inv;
      *(s16x4*)(Q + ooff + (size_t)(w * 16 * QT + qt * 16 + r) * PLD + dt * 16 + q * 4) = pack4(v);
    }
  }
}

DI void attn_item(char* smem, const Params& p, int layer, int item, int ooff) {
  const bool even = !(layer & 1); const int j = layer >> 1;
  bf* P = (bf*)(p.ws + OFF_P);
  const bf* KB = (const bf*)(p.ws + OFF_KB);
  const bf* VT = (const bf*)(p.ws + OFF_VT);
  if (even) {
    if (item < 1024) {
      const int b = item >> 7, qt = (item & 127) >> 2, hq = item & 3, kvh = hq >> 1;
      const size_t slot = (size_t)16 * 2 * 256 * 128 + (size_t)(b * 2 + kvh) * 4608 * 128;
      attn_tile<2, 0>(smem, P + (size_t)(TCTX + b * 4096 + qt * 128) * PLD + 2048 + hq * 128, ooff, KB + slot, VT + slot, 4608, 72, 0, 0, nullptr);
    } else if (item < 1152) {
      const int it = item - 1024, seq = it >> 3, qt = (it >> 2) & 1, hq = it & 3, kvh = hq >> 1;
      const size_t slot = (size_t)(seq * 2 + kvh) * 256 * 128;
      attn_tile<2, 0>(smem, P + (size_t)(seq * 256 + qt * 128) * PLD + 2048 + hq * 128, ooff, KB + slot, VT + slot, 256, 4, 0, 0, nullptr);
    }
  } else {
    if (item < 2048) {
      const int b = item >> 8, row = (item >> 2) & 63, h = item & 3;
      const size_t slot = (size_t)16 * 4 * 256 * 128 + (size_t)(b * 4 + h) * 4608 * 128;
      int r0 = row - 4; r0 = r0 < 0 ? 0 : (r0 > 56 ? 56 : r0);
      attn_tile<1, 1>(smem, P + (size_t)(TCTX + b * 4096 + row * 64) * PLD + 1536 + h * 128, ooff, KB + slot, VT + slot, 4608, 16, r0, row,
                      p.rpb + (size_t)(j * 4 + h) * 15 * 31);
    } else {
      const int it = item - 2048, seq = it >> 4, qt = (it >> 2) & 3, h = it & 3;
      const size_t slot = (size_t)(seq * 4 + h) * 256 * 128;
      attn_tile<1, 0>(smem, P + (size_t)(seq * 256 + qt * 64) * PLD + 1536 + h * 128, ooff, KB + slot, VT + slot, 256, 4, 0, 0, nullptr);
    }
  }
}

DI void gdn_prep_item(char* smem, const Params& p, int item) {
  const int cgk = item >> 1, d = item & 1;
  const int tid = tid_(), lane = tid & 63, w = tid >> 6, r = lane & 15, q = lane >> 4;
  float* Am = (float*)smem + w * (64 * 68 + 128);
  float* gcs = Am + 64 * 68; float* bes = gcs + 64;
  const float* bg = (const float*)(p.ws + OFF_BG);
  const bf* X = (const bf*)(p.ws + OFF_RX);
  const int prob = (cgk * 2 + d) * 4 + w;
  {
    const int tokl = cgk * 64 + (d ? 63 - lane : lane);
    const float g = bg[(size_t)tokl * 16 + 8 + d * 4 + w], be = bg[(size_t)tokl * 16 + d * 4 + w];
    float gc = g;
    UNROLL for (int off = 1; off < 64; off <<= 1) { const float t = __shfl_up(gc, off); if (lane >= off) gc += t; }
    gcs[lane] = gc; bes[lane] = be;
    ((float*)(p.ws + OFF_GC))[(size_t)prob * 64 + lane] = gc;
  }
  bf16x8 kf[4][4];
  UNROLL for (int t = 0; t < 4; ++t) {
    const int i = t * 16 + r;
    const int tk = cgk * 64 + (d ? 63 - i : i);
    UNROLL for (int ks = 0; ks < 4; ++ks) kf[t][ks] = *(const bf16x8*)(X + (size_t)tk * 1536 + 512 + w * 128 + ks * 32 + q * 8);
  }
  __syncthreads();
  UNROLL for (int it = 0; it < 4; ++it) UNROLL for (int jt = 0; jt < 4; ++jt) {
    if (jt <= it) {
      f32x4 acc = f32x4{0.f, 0.f, 0.f, 0.f};
      UNROLL for (int ks = 0; ks < 4; ++ks) acc = MFMA16(kf[it][ks], kf[jt][ks], acc);
      UNROLL for (int jj = 0; jj < 4; ++jj) {
        const int i = it * 16 + q * 4 + jj, jx = jt * 16 + r;
        Am[i * 68 + jx] = (jx < i) ? bes[i] * acc[jj] * __expf(gcs[i] - gcs[jx]) : 0.f;
      }
    }
  }
  __syncthreads();
  for (int i0 = 0; i0 < 64; i0 += 4) {
    float a0 = (i0 == lane) ? 1.f : 0.f, a1 = (i0 + 1 == lane) ? 1.f : 0.f, a2 = (i0 + 2 == lane) ? 1.f : 0.f, a3 = (i0 + 3 == lane) ? 1.f : 0.f;
    _Pragma("unroll 4") for (int jx = 0; jx < i0; jx += 4) {
      const float x0 = Am[jx * 68 + lane], x1 = Am[(jx + 1) * 68 + lane], x2 = Am[(jx + 2) * 68 + lane], x3 = Am[(jx + 3) * 68 + lane];
      const float4 r0 = *(const float4*)(Am + i0 * 68 + jx), r1 = *(const float4*)(Am + (i0 + 1) * 68 + jx);
      const float4 r2 = *(const float4*)(Am + (i0 + 2) * 68 + jx), r3 = *(const float4*)(Am + (i0 + 3) * 68 + jx);
      a0 -= r0.x * x0 + r0.y * x1 + r0.z * x2 + r0.w * x3;
      a1 -= r1.x * x0 + r1.y * x1 + r1.z * x2 + r1.w * x3;
      a2 -= r2.x * x0 + r2.y * x1 + r2.z * x2 + r2.w * x3;
      a3 -= r3.x * x0 + r3.y * x1 + r3.z * x2 + r3.w * x3;
    }
    const float4 t1 = *(const float4*)(Am + (i0 + 1) * 68 + i0), t2 = *(const float4*)(Am + (i0 + 2) * 68 + i0), t3 = *(const float4*)(Am + (i0 + 3) * 68 + i0);
    a1 -= t1.x * a0;
    a2 -= t2.x * a0 + t2.y * a1;
    a3 -= t3.x * a0 + t3.y * a1 + t3.z * a2;
    Am[i0 * 68 + lane] = a0; Am[(i0 + 1) * 68 + lane] = a1; Am[(i0 + 2) * 68 + lane] = a2; Am[(i0 + 3) * 68 + lane] = a3;
  }
  bf* Ti = (bf*)(p.ws + OFF_TINV) + (size_t)prob * 4096;
  for (int i = 0; i < 64; ++i) Ti[i * 64 + lane] = f2bf(Am[i * 68 + lane]);
}

DI void gdn_scan_item(char* smem, const Params& p, int j, int item) {
  const int tid = tid_(), lane = tid & 63, w = tid >> 6, r = lane & 15, q = lane >> 4;
  const bool lat = item < 256;
  const int it0 = lat ? item : item - 256;
  const int sq = it0 >> 5, h = (it0 >> 3) & 3, d = (it0 >> 2) & 1, sl = it0 & 3;
  const int NC = lat ? 64 : 4;
  const int cgbase = lat ? 64 + sq * 64 : sq * 4;
  bf* Kc = (bf*)smem;
  bf* KdT = Kc + 64 * 136;
  bf* St = KdT + 128 * 72;
  bf* RT = St + 32 * 136;
  bf* VnT = RT + 32 * 72;
  bf* Vc = VnT + 32 * 72;
  float* gcs = (float*)(Vc + 64 * 40); float* bes = gcs + 64;
  bf* VsT = (bf*)(bes + 64);
  const bf* X = (const bf*)(p.ws + OFF_RX);
  const float* bg = (const float*)(p.ws + OFF_BG);
  const float* GC = (const float*)(p.ws + OFF_GC);
  const bf* TINV = (const bf*)(p.ws + OFF_TINV);
  bf* P = (bf*)(p.ws + OFF_P);
  f32x4 accs[2][2];
  UNROLL for (int mt = 0; mt < 2; ++mt) UNROLL for (int nt = 0; nt < 2; ++nt) {
    UNROLL for (int jj = 0; jj < 4; ++jj) {
      const int dk = (2 * w + mt) * 16 + q * 4 + jj, dv = sl * 32 + nt * 16 + r;
      accs[mt][nt][jj] = lat ? p.state_gdn[((size_t)(((sq * 2 + j) * 2 + d) * 4 + h) * 128 + dk) * 128 + dv] : 0.f;
    }
    *(s16x4*)(St + (nt * 16 + r) * 136 + (2 * w + mt) * 16 + q * 4) = pack4(accs[mt][nt]);
  }
  bf16x8 pkv[4], pvv, qfr[4], tif[2];
  float pgc = 0.f, pbe = 0.f;
#define GDN_LOAD_STAGE(nn)                                                                                   \
  {                                                                                                          \
    const int tc_ = d ? NC - 1 - (nn) : (nn);                                                                \
    const int cg_ = cgbase + tc_;                                                                            \
    const int pr_ = (cg_ * 2 + d) * 4 + h;                                                                   \
    const int i_ = tid & 63, seg_ = tid >> 6;                                                                 \
    const int tk_ = cg_ * 64 + (d ? 63 - i_ : i_);                                                           \
    UNROLL for (int ii = 0; ii < 4; ++ii) pkv[ii] = *(const bf16x8*)(X + (size_t)tk_ * 1536 + 512 + h * 128 + seg_ * 32 + ii * 8); \
    pvv = *(const bf16x8*)(X + (size_t)tk_ * 1536 + 1024 + h * 128 + sl * 32 + seg_ * 8);                    \
    if (tid < 64) {                                                                                          \
      pgc = GC[(size_t)pr_ * 64 + tid];                                                                      \
      pbe = bg[(size_t)(cg_ * 64 + (d ? 63 - tid : tid)) * 16 + d * 4 + h];                                  \
    }                                                                                                        \
  }
#define GDN_LOAD_Q(nn)                                                                                       \
  {                                                                                                          \
    const int tc_ = d ? NC - 1 - (nn) : (nn);                                                                \
    const int cg_ = cgbase + tc_;                                                                            \
    const int iq_ = 16 * w + r;                                                                              \
    const int tq_ = cg_ * 64 + (d ? 63 - iq_ : iq_);                                                         \
    UNROLL for (int ks = 0; ks < 4; ++ks) qfr[ks] = *(const bf16x8*)(X + (size_t)tq_ * 1536 + h * 128 + ks * 32 + q * 8); \
  }
#define GDN_LOAD_T(nn)                                                                                       \
  {                                                                                                          \
    const int tc_ = d ? NC - 1 - (nn) : (nn);                                                                \
    const int pr_ = ((cgbase + tc_) * 2 + d) * 4 + h;                                                        \
    const int iq_ = 16 * w + r;                                                                              \
    UNROLL for (int k2 = 0; k2 < 2; ++k2) tif[k2] = *(const bf16x8*)(TINV + ((size_t)pr_ * 64 + iq_) * 64 + k2 * 32 + q * 8); \
  }
  GDN_LOAD_STAGE(0) GDN_LOAD_Q(0) GDN_LOAD_T(0)
  for (int n = 0; n < NC; ++n) {
    const int tc = d ? NC - 1 - n : n;
    const int cgk = cgbase + tc;
    {
      const int i = tid & 63, seg = tid >> 6;
      UNROLL for (int ii = 0; ii < 4; ++ii) {
        const bf16x8 kv = pkv[ii];
        *(bf16x8*)(Kc + i * 136 + seg * 32 + ii * 8) = kv;
        UNROLL for (int e = 0; e < 8; ++e) KdT[(seg * 32 + ii * 8 + e) * 72 + i] = (bf)kv[e];
      }
      *(bf16x8*)(Vc + i * 40 + seg * 8) = pvv;
      if (tid < 64) { gcs[tid] = pgc; bes[tid] = pbe; }
    }
    if (n + 1 < NC) GDN_LOAD_STAGE(n + 1)
    bar_lds();
    f32x4 ksa[2], qsa[2], qk[4];
    UNROLL for (int nt = 0; nt < 2; ++nt) { ksa[nt] = f32x4{0.f, 0.f, 0.f, 0.f}; qsa[nt] = f32x4{0.f, 0.f, 0.f, 0.f}; }
    UNROLL for (int jt = 0; jt < 4; ++jt) qk[jt] = f32x4{0.f, 0.f, 0.f, 0.f};
    UNROLL for (int ks = 0; ks < 4; ++ks) {
      const bf16x8 ka = *(const bf16x8*)(Kc + (16 * w + r) * 136 + ks * 32 + q * 8);
      UNROLL for (int nt = 0; nt < 2; ++nt) {
        const bf16x8 sb = *(const bf16x8*)(St + (nt * 16 + r) * 136 + ks * 32 + q * 8);
        ksa[nt] = MFMA16(ka, sb, ksa[nt]);
        qsa[nt] = MFMA16(qfr[ks], sb, qsa[nt]);
      }
      UNROLL for (int jt = 0; jt < 4; ++jt) {
        const bf16x8 kj = *(const bf16x8*)(Kc + (jt * 16 + r) * 136 + ks * 32 + q * 8);
        qk[jt] = MFMA16(kj, qfr[ks], qk[jt]);
      }
    }
    UNROLL for (int nt = 0; nt < 2; ++nt) {
      f32x4 rv;
      UNROLL for (int jj = 0; jj < 4; ++jj) {
        const int ii = 16 * w + q * 4 + jj;
        rv[jj] = bes[ii] * (bf2f(Vc[ii * 40 + nt * 16 + r]) - __expf(gcs[ii]) * ksa[nt][jj]);
      }
      *(s16x4*)(RT + (nt * 16 + r) * 72 + 16 * w + q * 4) = pack4(rv);
    }
    bf16x8 qkf[2];
    {
      const int ii = 16 * w + r; const float gi = gcs[ii];
      UNROLL for (int s2 = 0; s2 < 2; ++s2) UNROLL for (int e = 0; e < 8; ++e) {
        const int jt = 2 * s2 + (e >> 2);
        const int jx = jt * 16 + q * 4 + (e & 3);
        const float val = (jx <= ii) ? qk[jt][e & 3] * __expf(gi - gcs[jx]) : 0.f;
        qkf[s2][e] = (short)f2bf(val);
      }
    }
    if (n + 1 < NC) GDN_LOAD_Q(n + 1)
    bar_lds();
    f32x4 vn[2];
    UNROLL for (int nt = 0; nt < 2; ++nt) {
      vn[nt] = f32x4{0.f, 0.f, 0.f, 0.f};
      UNROLL for (int k2 = 0; k2 < 2; ++k2) {
        const bf16x8 rb = *(const bf16x8*)(RT + (nt * 16 + r) * 72 + k2 * 32 + q * 8);
        vn[nt] = MFMA16(tif[k2], rb, vn[nt]);
      }
      *(s16x4*)(VnT + (nt * 16 + r) * 72 + 16 * w + q * 4) = pack4(vn[nt]);
      f32x4 vs;
      UNROLL for (int jj = 0; jj < 4; ++jj) vs[jj] = vn[nt][jj] * __expf(gcs[63] - gcs[16 * w + q * 4 + jj]);
      *(s16x4*)(VsT + (nt * 16 + r) * 72 + 16 * w + q * 4) = pack4(vs);
    }
    if (n + 1 < NC) GDN_LOAD_T(n + 1)
    bar_lds();
    UNROLL for (int nt = 0; nt < 2; ++nt) {
      f32x4 oa = f32x4{0.f, 0.f, 0.f, 0.f};
      UNROLL for (int s2 = 0; s2 < 2; ++s2) {
        const s16x4 lo = *(const s16x4*)(VnT + (nt * 16 + r) * 72 + s2 * 32 + q * 4);
        const s16x4 hi = *(const s16x4*)(VnT + (nt * 16 + r) * 72 + s2 * 32 + 16 + q * 4);
        oa = MFMA16(qkf[s2], cat8(lo, hi), oa);
      }
      UNROLL for (int jj = 0; jj < 4; ++jj) {
        const int i = 16 * w + q * 4 + jj;
        const int tk = cgk * 64 + (d ? 63 - i : i);
        const float ov = __expf(gcs[i]) * qsa[nt][jj] + oa[jj];
        P[(size_t)tk * PLD + d * 512 + h * 128 + sl * 32 + nt * 16 + r] = f2bf(ov);
      }
    }
    {
      const float gt = __expf(gcs[63]);
      UNROLL for (int mt = 0; mt < 2; ++mt) UNROLL for (int nt = 0; nt < 2; ++nt) {
        f32x4 a = accs[mt][nt]; a *= gt;
        UNROLL for (int k2 = 0; k2 < 2; ++k2) {
          const bf16x8 ka = *(const bf16x8*)(KdT + ((2 * w + mt) * 16 + r) * 72 + k2 * 32 + q * 8);
          const bf16x8 vb = *(const bf16x8*)(VsT + (nt * 16 + r) * 72 + k2 * 32 + q * 8);
          a = MFMA16(ka, vb, a);
        }
        accs[mt][nt] = a;
        *(s16x4*)(St + (nt * 16 + r) * 136 + (2 * w + mt) * 16 + q * 4) = pack4(a);
      }
    }
    bar_lds();
  }
  if (!lat) {
    UNROLL for (int mt = 0; mt < 2; ++mt) UNROLL for (int nt = 0; nt < 2; ++nt) UNROLL for (int jj = 0; jj < 4; ++jj) {
      const int dk = (2 * w + mt) * 16 + q * 4 + jj, dv = sl * 32 + nt * 16 + r;
      p.out[OUT_GDN + ((size_t)(((sq * 2 + j) * 2 + d) * 4 + h) * 128 + dk) * 128 + dv] = accs[mt][nt][jj];
    }
  }
}

DI void ssd_scan_item(char* smem, const Params& p, int j, int item) {
  const int tid = tid_(), lane = tid & 63, w = tid >> 6, r = lane & 15, q = lane >> 4;
  const bool lat = item < 256;
  const int it0 = lat ? item : item - 256;
  const int sq = it0 >> 5, hh = (it0 >> 2) & 7, d = (it0 >> 1) & 1, ps = it0 & 1;
  const int NC = lat ? 64 : 4;
  const int cgbase = lat ? 64 + sq * 64 : sq * 4;
  const int gq = hh >> 2;
  bf* Bc = (bf*)smem;
  bf* BT = Bc + 64 * 136;
  bf* XT = BT + 128 * 72;
  bf* XdT = XT + 32 * 72;
  bf* Hb = XdT + 32 * 72;
  float* css = (float*)(Hb + 32 * 136); float* dts = css + 64;
  const bf* X = (const bf*)(p.ws + OFF_RX);
  const float* bg = (const float*)(p.ws + OFF_BG);
  bf* P = (bf*)(p.ws + OFF_P);
  const float a = -expf(p.ssd_alog[j * 16 + d * 8 + hh]);
  f32x4 acch[2][2];
  UNROLL for (int ntl = 0; ntl < 2; ++ntl) UNROLL for (int mt = 0; mt < 2; ++mt) {
    f32x4 v = f32x4{0.f, 0.f, 0.f, 0.f};
    if (lat) {
      const float4 t = *(const float4*)(p.state_ssd + ((size_t)(((sq * 2 + j) * 2 + d) * 8 + hh) * 64 + ps * 32 + mt * 16 + r) * 128 + (2 * w + ntl) * 16 + q * 4);
      v[0] = t.x; v[1] = t.y; v[2] = t.z; v[3] = t.w;
    }
    acch[ntl][mt] = v;
    *(s16x4*)(Hb + (mt * 16 + r) * 136 + (2 * w + ntl) * 16 + q * 4) = pack4(v);
  }
  bf16x8 pbv[4], pxv, cf[4];
  float pdt = 0.f;
#define SSD_LOAD_STAGE(nn)                                                                                   \
  {                                                                                                          \
    const int tc_ = d ? NC - 1 - (nn) : (nn);                                                                \
    const int cg_ = cgbase + tc_;                                                                            \
    pdt = bg[(size_t)(cg_ * 64 + (d ? 63 - lane : lane)) * 16 + d * 8 + hh];                                 \
    const int i_ = tid & 63, seg_ = tid >> 6;                                                                 \
    const int tk_ = cg_ * 64 + (d ? 63 - i_ : i_);                                                           \
    UNROLL for (int ii = 0; ii < 4; ++ii) pbv[ii] = *(const bf16x8*)(X + (size_t)tk_ * 1024 + 512 + gq * 128 + seg_ * 32 + ii * 8); \
    pxv = *(const bf16x8*)(X + (size_t)tk_ * 1024 + hh * 64 + ps * 32 + seg_ * 8);                           \
  }
#define SSD_LOAD_C(nn)                                                                                       \
  {                                                                                                          \
    const int tc_ = d ? NC - 1 - (nn) : (nn);                                                                \
    const int cg_ = cgbase + tc_;                                                                            \
    const int l_ = 16 * w + r;                                                                               \
    const int tq_ = cg_ * 64 + (d ? 63 - l_ : l_);                                                           \
    UNROLL for (int ks = 0; ks < 4; ++ks) cf[ks] = *(const bf16x8*)(X + (size_t)tq_ * 1024 + 768 + gq * 128 + ks * 32 + q * 8); \
  }
  SSD_LOAD_STAGE(0) SSD_LOAD_C(0)
  for (int n = 0; n < NC; ++n) {
    const int tc = d ? NC - 1 - n : n;
    const int cgk = cgbase + tc;
    float cs, dtl;
    {
      dtl = pdt;
      cs = dtl * a;
      UNROLL for (int off = 1; off < 64; off <<= 1) { const float t = __shfl_up(cs, off); if (lane >= off) cs += t; }
      if (w == 0) { css[lane] = cs; dts[lane] = dtl; }
    }
    {
      const int i = tid & 63, seg = tid >> 6;
      const float cs_i = __shfl(cs, i & 63), dt_i = __shfl(dtl, i & 63), cs_l = __shfl(cs, 63);
      const float xs = dt_i * __expf(cs_l - cs_i);
      UNROLL for (int ii = 0; ii < 4; ++ii) {
        const bf16x8 bv = pbv[ii];
        *(bf16x8*)(Bc + i * 136 + seg * 32 + ii * 8) = bv;
        UNROLL for (int e = 0; e < 8; ++e) BT[(seg * 32 + ii * 8 + e) * 72 + i] = (bf)bv[e];
      }
      const bf16x8 xv = pxv;
      UNROLL for (int e = 0; e < 8; ++e) {
        XT[(seg * 8 + e) * 72 + i] = (bf)xv[e];
        XdT[(seg * 8 + e) * 72 + i] = f2bf(bf2f((bf)xv[e]) * xs);
      }
    }
    if (n + 1 < NC) SSD_LOAD_STAGE(n + 1)
    bar_lds();
    f32x4 gT[4], yo[2];
    UNROLL for (int st = 0; st < 4; ++st) gT[st] = f32x4{0.f, 0.f, 0.f, 0.f};
    UNROLL for (int mt = 0; mt < 2; ++mt) yo[mt] = f32x4{0.f, 0.f, 0.f, 0.f};
    UNROLL for (int ks = 0; ks < 4; ++ks) {
      UNROLL for (int st = 0; st < 4; ++st) {
        const bf16x8 bs = *(const bf16x8*)(Bc + (st * 16 + r) * 136 + ks * 32 + q * 8);
        gT[st] = MFMA16(bs, cf[ks], gT[st]);
      }
      UNROLL for (int mt = 0; mt < 2; ++mt) {
        const bf16x8 hb = *(const bf16x8*)(Hb + (mt * 16 + r) * 136 + ks * 32 + q * 8);
        yo[mt] = MFMA16(cf[ks], hb, yo[mt]);
      }
    }
    if (n + 1 < NC) SSD_LOAD_C(n + 1)
    bf16x8 mf[2];
    {
      const int ll = 16 * w + r; const float cl = css[ll];
      UNROLL for (int s2 = 0; s2 < 2; ++s2) UNROLL for (int e = 0; e < 8; ++e) {
        const int st = 2 * s2 + (e >> 2);
        const int sx = st * 16 + q * 4 + (e & 3);
        const float val = (sx <= ll) ? gT[st][e & 3] * __expf(cl - css[sx]) * dts[sx] : 0.f;
        mf[s2][e] = (short)f2bf(val);
      }
    }
    UNROLL for (int mt = 0; mt < 2; ++mt) {
      f32x4 ya;
      UNROLL for (int jj = 0; jj < 4; ++jj) ya[jj] = yo[mt][jj] * __expf(css[16 * w + q * 4 + jj]);
      UNROLL for (int s2 = 0; s2 < 2; ++s2) {
        const s16x4 lo = *(const s16x4*)(XT + (mt * 16 + r) * 72 + s2 * 32 + q * 4);
        const s16x4 hi = *(const s16x4*)(XT + (mt * 16 + r) * 72 + s2 * 32 + 16 + q * 4);
        ya = MFMA16(mf[s2], cat8(lo, hi), ya);
      }
      UNROLL for (int jj = 0; jj < 4; ++jj) {
        const int l = 16 * w + q * 4 + jj;
        const int tk = cgk * 64 + (d ? 63 - l : l);
        P[(size_t)tk * PLD + 512 + d * 512 + hh * 64 + ps * 32 + mt * 16 + r] = f2bf(ya[jj]);
      }
    }
    {
      const float cd = __expf(css[63]);
      UNROLL for (int ntl = 0; ntl < 2; ++ntl) UNROLL for (int mt = 0; mt < 2; ++mt) {
        f32x4 v = acch[ntl][mt]; v *= cd;
        UNROLL for (int k2 = 0; k2 < 2; ++k2) {
          const bf16x8 ba = *(const bf16x8*)(BT + ((2 * w + ntl) * 16 + r) * 72 + k2 * 32 + q * 8);
          const bf16x8 xb = *(const bf16x8*)(XdT + (mt * 16 + r) * 72 + k2 * 32 + q * 8);
          v = MFMA16(ba, xb, v);
        }
        acch[ntl][mt] = v;
      }
    }
    bar_lds();
    UNROLL for (int ntl = 0; ntl < 2; ++ntl) UNROLL for (int mt = 0; mt < 2; ++mt)
      *(s16x4*)(Hb + (mt * 16 + r) * 136 + (2 * w + ntl) * 16 + q * 4) = pack4(acch[ntl][mt]);
  }
  if (!lat) {
    UNROLL for (int ntl = 0; ntl < 2; ++ntl) UNROLL for (int mt = 0; mt < 2; ++mt) {
      const f32x4 v = acch[ntl][mt];
      *(float4*)(p.out + OUT_SSD + ((size_t)(((sq * 2 + j) * 2 + d) * 8 + hh) * 64 + ps * 32 + mt * 16 + r) * 128 + (2 * w + ntl) * 16 + q * 4) =
          make_float4(v[0], v[1], v[2], v[3]);
    }
  }
}

DI void gate_item(const Params& p, int layer, int item) {
  const bool even = !(layer & 1); const int j = layer >> 1;
  const int tid = tid_(), lane = tid & 63, w = tid >> 6;
  bf* P = (bf*)(p.ws + OFF_P);
  for (int tt = 0; tt < 4; ++tt) {
    const int tok = item * 16 + w * 4 + tt;
    bf* pr = P + (size_t)tok * PLD;
    if (even) {
      for (int h = 0; h < 4; ++h) {
        const int c = h * 128 + lane * 2;
        const unsigned u0 = *(const unsigned*)(pr + c), u1 = *(const unsigned*)(pr + 512 + c), uz = *(const unsigned*)(pr + 1536 + c);
        const float o0 = bflo(u0) + bflo(u1), o1 = bfhi(u0) + bfhi(u1);
        const float ss = wave_sum(o0 * o0 + o1 * o1);
        const float rstd = rsqrtf(ss * (1.f / 128.f) + EPSF);
        const float2 gn = *(const float2*)(p.gdn_norm + j * 128 + lane * 2);
        *(unsigned*)(pr + c) = packbf(o0 * rstd * gn.x * silu(bflo(uz)), o1 * rstd * gn.y * silu(bfhi(uz)));
      }
    } else {
      const int c = lane * 8;
      float y0[8], y1[8], xh[8], z[8], y[8];
      unpack8(*(const bf16x8*)(pr + 512 + c), y0);
      unpack8(*(const bf16x8*)(pr + 1024 + c), y1);
      unpack8(*(const bf16x8*)(pr + c), z);
      unpack8(*(const bf16x8*)((const bf*)(p.ws + OFF_RX) + (size_t)tok * 1024 + c), xh);
      const float dsk = p.ssd_d[j * 8 + (c >> 6)];
      float ss = 0.f;
      UNROLL for (int e = 0; e < 8; ++e) { y[e] = (y0[e] + y1[e] + xh[e] * dsk) * silu(z[e]); ss += y[e] * y[e]; }
      ss = wave_sum(ss);
      const float rstd = rsqrtf(ss * (1.f / 512.f) + EPSF);
      const float* sn = p.ssd_norm + j * 512 + c;
      bf16x8 o;
      UNROLL for (int e = 0; e < 8; ++e) o[e] = (short)f2bf(y[e] * rstd * sn[e]);
      *(bf16x8*)(pr + 512 + c) = o;
    }
  }
}


#define XB_TMO      128
#define XB_XCNT(j)  (256  + 64 * (j))
#define XB_XSUB(j)  (1280 + 64 * (j))
#define XB_XGEN(j)  (2304 + 64 * (j))
#define XB_TOP      3328
#define XB_TOPGEN   3392
#define XB_SPIN_CAP (1u << 20)
DI unsigned xb_ld(unsigned* p)              { return __hip_atomic_load(p, __ATOMIC_RELAXED, __HIP_MEMORY_SCOPE_AGENT); }
DI unsigned xb_add(unsigned* p, unsigned v) { return __hip_atomic_fetch_add(p, v, __ATOMIC_RELAXED, __HIP_MEMORY_SCOPE_AGENT); }
#define XB_SPIN(cond, bar) do { unsigned _sp = 0; while (cond) { __builtin_amdgcn_s_sleep(1); \
    if ((++_sp & 255u) == 0u) { if (xb_ld(&(bar)[XB_TMO])) break; if (_sp > XB_SPIN_CAP) { atomicAdd(&(bar)[XB_TMO], 1u); break; } } } } while (0)
DI void xcd_barrier_complete(unsigned* bar, unsigned x, unsigned& nloc, unsigned& nx) {
  const unsigned G = gridDim.x;
  unsigned sum, cnt, mine, sp = 0u;
  for (;;) {
    sum = 0u; cnt = 0u; mine = 0u;
    UNROLL for (unsigned jx = 0; jx < 16; ++jx) { const unsigned c = xb_ld(&bar[XB_XCNT(jx)]); sum += c; cnt += (c > 0u) ? 1u : 0u; mine = (jx == x) ? c : mine; }
    if (sum == G) break;
    __builtin_amdgcn_s_sleep(1);
    if ((++sp & 255u) == 0u) { if (xb_ld(&bar[XB_TMO])) break; if (sp > XB_SPIN_CAP) { atomicAdd(&bar[XB_TMO], 1u); break; } }
  }
  nloc = mine > 0u ? mine : 1u; nx = cnt > 0u ? cnt : 1u;
}
DI void xcd_barrier(unsigned* bar, unsigned x, volatile unsigned* st) {
  asm volatile("s_waitcnt vmcnt(0)" ::: "memory");
  __syncthreads();
  if (threadIdx.x == 0) {
    __builtin_amdgcn_s_waitcnt(0);
    unsigned nloc = st[0], nx = st[1];
    if (nloc == 0u) { xcd_barrier_complete(bar, x, nloc, nx); st[0] = nloc; st[1] = nx; }
    const unsigned old = xb_add(&bar[XB_XSUB(x)], 1u);
    const unsigned gen = old / nloc;
    if (old + 1u == (gen + 1u) * nloc) {
      __builtin_amdgcn_fence(__ATOMIC_RELEASE, "agent");
      asm volatile("s_waitcnt vmcnt(0)" ::: "memory");
      const unsigned og = xb_add(&bar[XB_TOP], 1u);
      const unsigned tg = og / nx;
      if (og + 1u == (tg + 1u) * nx) xb_add(&bar[XB_TOPGEN], 1u);
      else XB_SPIN(xb_ld(&bar[XB_TOPGEN]) == tg, bar);
      __builtin_amdgcn_fence(__ATOMIC_ACQUIRE, "agent");
      xb_add(&bar[XB_XGEN(x)], 1u);
      asm volatile("s_waitcnt vmcnt(0)" ::: "memory");
    } else {
      XB_SPIN(xb_ld(&bar[XB_XGEN(x)]) == gen, bar);
      __builtin_amdgcn_fence(__ATOMIC_ACQUIRE, "agent");
      asm volatile("s_waitcnt vmcnt(0)" ::: "memory");
    }
  }
  __syncthreads();
}
#define GRID_SEAM() { if (phase == 2) grid.sync(); else xcd_barrier(xbar, xb_x, xb_st); }

#define FOR_ITEMS(N, ...)                                                               \
  {                                                                                     \
    const int n_items_ = (N);                                                           \
    for (;;) {                                                                          \
      __syncthreads();                                                                  \
      if (threadIdx.x == 0) s_item = atomicAdd(ctr + phase * 8, 1);                     \
      __syncthreads();                                                                  \
      const int item = 2 * s_item + half;     \
      if (item - half >= n_items_) break;                                               \
      if (item < n_items_) { __VA_ARGS__ }                                              \
    }                                                                                   \
    ++phase;                                                                            \
    GRID_SEAM()                                                                         \
  }

#define FOR_GEMM(MTOT, NP, NTN, EXTRA, ...)                                                   \
  {                                                                                     \
    constexpr int np_ = (NP), npx_ = (NTN) / (NP), mp_ = (MTOT) / (8 / (NP));              \
    constexpr int cnt_ = mp_ * npx_;                                                    \
    int xq_ = (int)(xcc_id() & 7u), tries_ = 0;                                         \
    for (;;) {                                                                          \
      __syncthreads();                                                                  \
      if (threadIdx.x == 0) {                                                           \
        int it_ = -1;                                                                   \
        while (tries_ < 8) {                                                            \
          const int li_ = atomicAdd(ctr + phase * 8 + xq_, 1);                          \
          if (li_ < cnt_) {                                                             \
            const int mt_ = (xq_ / np_) * mp_ + li_ / npx_;                             \
            const int nt_ = (xq_ % np_) * npx_ + li_ % npx_;                            \
            it_ = (mt_ << 6) | nt_;                                                     \
            break;                                                                      \
          } else if (li_ < cnt_ + (EXTRA)) {                                            \
            it_ = ((xq_ * (EXTRA) + li_ - cnt_) << 6) | 63;                             \
            break;                                                                      \
          }                                                                             \
          xq_ = (xq_ + 1) & 7; ++tries_;                                                \
        }                                                                               \
        s_item = it_;                                                                   \
      }                                                                                 \
      __syncthreads();                                                                  \
      const int item = s_item;                                                          \
      if (item < 0) break;                                                              \
      const int mt = item >> 6, nt = item & 63;                                         \
      __VA_ARGS__                                                                       \
    }                                                                                   \
    ++phase;                                                                            \
    GRID_SEAM()                                                                         \
  }

__global__ void __launch_bounds__(512) hybrid_dit_megakernel(Params p) {
  cg::grid_group grid = cg::this_grid();
  __shared__ __attribute__((aligned(16))) char smem_all[2 * SMEM_BYTES];
  const int half = threadIdx.x >> 8;
  char* smem = smem_all + half * SMEM_BYTES;
  __shared__ int s_item;
  int* ctr = (int*)(p.ws + OFF_CTR);
  int phase = 0;
  __shared__ unsigned xb_st_s[2];
  volatile unsigned* xb_st = xb_st_s;
  unsigned* xbar = (unsigned*)(p.ws + OFF_XBAR);
  const unsigned xb_x = xcc_id();
  if (threadIdx.x == 0) { xb_st[0] = 0u; xb_st[1] = 0u; (void)xb_add(&xbar[XB_XCNT(xb_x)], 1u); }
  __syncthreads();

  bf* RX = (bf*)(p.ws + OFF_RX);
  bf* P = (bf*)(p.ws + OFF_P);
  const bf* HB = (const bf*)(p.ws + OFF_H);

  FOR_ITEMS(3104 + 384 + 1, {
    if (item < 3104) convert_item(smem, p, 0, item);
    else if (item < 3488) mod_item(smem, p, item - 3104);
    else rope_item(p);
  })
  FOR_ITEMS(2304, { for (int tt = 0; tt < 4; ++tt) rowpass<0>(p, 0, item * 16 + (tid_() >> 6) * 4 + tt); })

  for (int layer = 0; layer < 4; ++layer) {
    const bool even = !(layer & 1);
    const int j = layer >> 1;
    FOR_GEMM(144, 4, 12, 18, {
      if (nt < 63) gemm512<256, 1, 1, 1>(smem_all, HB, HB, 0, 1 << 30, (const bf*)(p.ws + OFF_WIN), 3200, 1024, mt * 256, nt * 256, P, PLD);
      else gates_tile(HB, (const bf*)(p.ws + OFF_WIN), mt * 256, (float*)(p.ws + OFF_GATES));
    })
    {
      const int nkv = even ? (128 + 1152) : (256 + 2304);
      const int nq = even ? 2304 : 0;
      FOR_ITEMS(2304 + nkv + nq, {
        if (item < 2304) conv_item(p, layer, item);
        else if (item < 2304 + nkv) kvprep_item(smem, p, layer, item - 2304);
        else qprep_item(p, layer, item - 2304 - nkv);
      })
    }
#if PROBE == 3
    FOR_ITEMS(2304, { attn_item(smem, p, layer, item, even ? -1024 : 512); })
#endif
#if PROBE == 4
    if (even) { FOR_ITEMS(1152, { gdn_prep_item(smem, p, item); }) }
#endif
    if (even) {
      FOR_ITEMS(1152, { gdn_prep_item(smem, p, item); })
#if PROBE == 2
      FOR_ITEMS(768, { gdn_scan_item(smem, p, j, item); })
#endif
      FOR_ITEMS(768 + 1152, {
        if (item < 768) gdn_scan_item(smem, p, j, item);
        else attn_item(smem, p, layer, item - 768, 0);
      })
    } else {
#if PROBE == 2
      FOR_ITEMS(768, { ssd_scan_item(smem, p, j, item); })
#endif
      FOR_ITEMS(768 + 2304, {
        if (item < 768) ssd_scan_item(smem, p, j, item);
        else attn_item(smem, p, layer, item - 768, 0);
      })
    }
    FOR_ITEMS(2304, { gate_item(p, layer, item); })
    FOR_GEMM(144, 1, 8, 0, {
      gemm512<128, 1, 0, 0>(smem_all, P + (even ? 0 : 512), P + (even ? 2048 : 1536), PLD, 512, (const bf*)(p.ws + OFF_WOUT), 1024, 1024, mt * 256, nt * 128, RX, 1024);
    })
    FOR_ITEMS(2304, { for (int tt = 0; tt < 4; ++tt) rowpass<1>(p, layer, item * 16 + (tid_() >> 6) * 4 + tt); })
#if PROBE == 1
    FOR_GEMM(144, 8, 16, 0, {
      gemm512<256, 2, 1, 1>(smem_all, HB, HB, 0, 1 << 30, (const bf*)(p.ws + OFF_W1), 4096, 1024, mt * 256, nt * 256, P, 4096);
    })
#endif
#if PROBE == 5
    FOR_GEMM(144, 4, 8, 0, {
      gemm512<128, 1, 1, 1>(smem_all, P, P, 0, 1 << 30, (const bf*)(p.ws + OFF_W2), 1024, 4096, mt * 256, nt * 128, RX, 1024);
    })
#endif
    FOR_GEMM(144, 4, 16, 0, {
      gemm512<256, 2, 1, 1>(smem_all, HB, HB, 0, 1 << 30, (const bf*)(p.ws + OFF_W1), 4096, 1024, mt * 256, nt * 256, P, 4096);
    })
    FOR_GEMM(144, 4, 8, 0, {
      gemm512<128, 1, 1, 1>(smem_all, P, P, 0, 1 << 30, (const bf*)(p.ws + OFF_W2), 1024, 4096, mt * 256, nt * 128, RX, 1024);
    })
    {
      const int ncv = layer < 3 ? 3104 : 0;
      FOR_ITEMS(2304 + ncv, {
        if (item < 2304) { for (int tt = 0; tt < 4; ++tt) rowpass<2>(p, layer, item * 16 + (tid_() >> 6) * 4 + tt); }
        else convert_item(smem, p, layer + 1, item - 2304);
      })
    }
  }
}

extern "C" void kernel_launch(void* const* d_in, const int* in_sizes, int n_in, void* d_out, int out_size, void* d_ws,
                              size_t ws_size, hipStream_t stream) {
  (void)in_sizes; (void)n_in; (void)out_size;
  static int grid_blocks = 0;
  if (!grid_blocks) {
    int dev = 0, cus = 0, per_cu = 0;
    hipGetDevice(&dev);
    hipDeviceGetAttribute(&cus, hipDeviceAttributeMultiprocessorCount, dev);
    hipOccupancyMaxActiveBlocksPerMultiprocessor(&per_cu, hybrid_dit_megakernel, 512, 0);
    if (per_cu > 1) per_cu = 1;
    if (per_cu < 1) per_cu = 1;
    grid_blocks = cus * per_cu;
  }
  if (ws_size < WS_END) fprintf(stderr, "workspace too small: %zu < %zu\n", ws_size, (size_t)WS_END);
  Params p{};
  const float** f = (const float**)&p;
  for (int i = 0; i < 35; ++i) f[i] = (const float*)d_in[i];
  p.out = (float*)d_out;
  p.ws = (char*)d_ws;
  hipMemsetAsync((char*)d_ws + OFF_CTR, 0, 4096 + 16384, stream);
  void* args[] = {&p};
  hipError_t e = hipLaunchCooperativeKernel((void*)hybrid_dit_megakernel, dim3(grid_blocks), dim3(512), args, 0, stream);
  if (e != hipSuccess) fprintf(stderr, "cooperative launch failed: %s (grid %d)\n", hipGetErrorString(e), grid_blocks);
}
```

```cpp
#include <hip/hip_runtime.h>
#include <hip/hip_cooperative_groups.h>
#include <cstdio>
namespace cg = cooperative_groups;
#ifndef PROBE
#define PROBE 0
#endif

typedef unsigned short bf;
using bf16x8 = __attribute__((ext_vector_type(8))) short;
using s16x4  = __attribute__((ext_vector_type(4))) short;
using f32x4  = __attribute__((ext_vector_type(4))) float;
#define DI __device__ __forceinline__
#define MFMA16(a, b, c) __builtin_amdgcn_mfma_f32_16x16x32_bf16((a), (b), (c), 0, 0, 0)
#define UNROLL _Pragma("unroll")

constexpr int TCTX = 4096, TALL = 36864, PLD = 3072;
constexpr float EPSF = 1e-6f;
constexpr int SMEM_BYTES = 73728;

constexpr size_t OFF_WIN  = 0;
constexpr size_t OFF_WOUT = OFF_WIN + 6553600;
constexpr size_t OFF_W1   = OFF_WOUT + 2097152;
constexpr size_t OFF_W2   = OFF_W1 + 8388608;
constexpr size_t OFF_MOD  = OFF_W2 + 8388608;
constexpr size_t OFF_ROPE = OFF_MOD + 884736;
constexpr size_t OFF_CTR  = OFF_ROPE + 16384;
constexpr size_t OFF_XBAR = OFF_CTR + 4096;
constexpr size_t OFF_RX   = OFF_XBAR + 16384;
constexpr size_t OFF_H    = OFF_RX + 75497472;
constexpr size_t OFF_P    = OFF_RX + 150994944;
constexpr size_t OFF_GATES= OFF_P + 226492416;
constexpr size_t OFF_BG   = OFF_GATES + 2359296;
constexpr size_t OFF_TINV = OFF_BG + 2359296;
constexpr size_t OFF_GC   = OFF_TINV + 37748736;
constexpr size_t OFF_KB   = OFF_GC + 1179648;
constexpr size_t OFF_VT   = OFF_KB + 41943040;
constexpr size_t WS_END   = OFF_VT + 41943040;

constexpr size_t OUT_GDN = 37748736, OUT_GK = 41943040, OUT_GV = 44040192, OUT_SSD = 46137344,
                 OUT_NK = 50331648, OUT_NV = 54525952;

struct Params {
  const float *x_prompt, *x_sample, *state_gdn, *cgk, *cgv, *state_ssd, *cnk, *cnv, *c, *c_ctx, *ada_w, *ada_b,
      *n_mix_pre, *n_mix_post, *n_mlp_pre, *n_mlp_post, *w1, *w2, *ev_in, *ev_out, *gdn_conv, *gdn_alog, *gdn_dtb,
      *gdn_norm, *q_norm, *k_norm, *od_in, *od_out, *ssd_conv, *ssd_conv_b, *ssd_alog, *ssd_dtb, *ssd_d, *ssd_norm, *rpb;
  float* out;
  char* ws;
};

DI int tid_() { int t = threadIdx.x & 255; asm volatile("" : "+v"(t)); return t; }
DI int tid512_() { int t = threadIdx.x; asm volatile("" : "+v"(t)); return t; }
typedef __bf16 bf16x2_t __attribute__((ext_vector_type(2)));
typedef float f32x2_t __attribute__((ext_vector_type(2)));
DI unsigned cvtpk(float a, float b) { f32x2_t f = {a, b}; bf16x2_t h = __builtin_convertvector(f, bf16x2_t); return __builtin_bit_cast(unsigned, h); }
DI bf f2bf(float x) { return (bf)(cvtpk(x, x) & 0xffffu); }
DI float bf2f(bf b) { return __uint_as_float(((unsigned)b) << 16); }
DI float bflo(unsigned u) { return __uint_as_float(u << 16); }
DI float bfhi(unsigned u) { return __uint_as_float(u & 0xffff0000u); }
DI unsigned packbf(float a, float b) { return cvtpk(a, b); }
DI float silu(float v) { return v / (1.f + __expf(-v)); }
DI float softplus(float v) { return v > 20.f ? v : log1pf(expf(v)); }
DI float wave_sum(float v) { UNROLL for (int o = 32; o >= 1; o >>= 1) v += __shfl_xor(v, o); return v; }
DI s16x4 pack4(f32x4 v) { const unsigned a = cvtpk(v[0], v[1]), b = cvtpk(v[2], v[3]); using u32x2 = __attribute__((ext_vector_type(2))) unsigned; u32x2 t = {a, b}; return __builtin_bit_cast(s16x4, t); }
DI bf16x8 cat8(s16x4 lo, s16x4 hi) { return __builtin_shufflevector(lo, hi, 0, 1, 2, 3, 4, 5, 6, 7); }
DI void unpack8(bf16x8 v, float* f) { UNROLL for (int e = 0; e < 8; ++e) f[e] = bf2f((bf)v[e]); }


DI void half_barrier(int* ctr, int& gen, int lane) {
  asm volatile("s_waitcnt vmcnt(0) lgkmcnt(0)" ::: "memory");
  gen += 4;
  if (lane == 0) {
    __hip_atomic_fetch_add(ctr, 1, __ATOMIC_RELAXED, __HIP_MEMORY_SCOPE_WORKGROUP);
    while (__hip_atomic_load(ctr, __ATOMIC_RELAXED, __HIP_MEMORY_SCOPE_WORKGROUP) < gen) __builtin_amdgcn_s_sleep(1);
  }
  asm volatile("s_waitcnt lgkmcnt(0)" ::: "memory");
}

DI void bar_lds() { asm volatile("s_waitcnt lgkmcnt(0)" ::: "memory"); __builtin_amdgcn_s_barrier(); asm volatile("" ::: "memory"); }

DI void convert_tile(char* smem, const float* src, int ldsrc, int gs, bf* dst, int K, int n0, int k0, int nrows) {
  float* tile = (float*)smem;
  const int tid = tid_();
  const int kr = tid >> 2, nc = (tid & 3) * 16;
  const int n = n0 + nc;
  int srcn = n;
  if (gs >= 0) srcn = (n < gs) ? n : (n < 3072 ? n + 16 : (n < 3088 ? gs + n - 3072 : -1));
  UNROLL for (int e4 = 0; e4 < 4; ++e4) {
    float4 v = make_float4(0.f, 0.f, 0.f, 0.f);
    if (srcn >= 0) v = *(const float4*)(src + (size_t)(k0 + kr) * ldsrc + srcn + e4 * 4);
    float* t = tile + kr * 65 + nc + e4 * 4;
    t[0] = v.x; t[1] = v.y; t[2] = v.z; t[3] = v.w;
  }
  __syncthreads();
  const int nn = tid >> 2, ks = (tid & 3) * 16;
  bf16x8 o0, o1;
  UNROLL for (int e = 0; e < 8; ++e) { o0[e] = (short)f2bf(tile[(ks + e) * 65 + nn]); o1[e] = (short)f2bf(tile[(ks + 8 + e) * 65 + nn]); }
  bf* d = nrows ? dst + ((size_t)((k0 + ks) >> 5) * nrows + n0 + nn) * 32 + ((k0 + ks) & 31)
                : dst + (size_t)(n0 + nn) * K + k0 + ks;
  *(bf16x8*)d = o0; *(bf16x8*)(d + 8) = o1;
}

DI void convert_item(char* smem, const Params& p, int layer, int item) {
  const int j = layer >> 1; const bool even = !(layer & 1);
  if (item < 800) {
    const float* src = (even ? p.ev_in : p.od_in) + (size_t)j * 1024 * 3088;
    convert_tile(smem, src, 3088, even ? 2048 : 1536, (bf*)(p.ws + OFF_WIN), 1024, (item >> 4) * 64, (item & 15) * 64, 3200);
  } else if (item < 1056) {
    item -= 800;
    const float* src = (even ? p.ev_out : p.od_out) + (size_t)j * 1024 * 1024;
    convert_tile(smem, src, 1024, -1, (bf*)(p.ws + OFF_WOUT), 1024, (item >> 4) * 64, (item & 15) * 64, 0);
  } else if (item < 2080) {
    item -= 1056;
    convert_tile(smem, p.w1 + (size_t)layer * 1024 * 4096, 4096, -1, (bf*)(p.ws + OFF_W1), 1024, (item >> 4) * 64, (item & 15) * 64, 4096);
  } else {
    item -= 2080;
    convert_tile(smem, p.w2 + (size_t)layer * 4096 * 1024, 1024, -1, (bf*)(p.ws + OFF_W2), 4096, (item >> 6) * 64, (item & 63) * 64, 1024);
  }
}

DI void mod_item(char* smem, const Params& p, int item) {
  const int l = item / 96, cb = item % 96, tid = tid_();
  float* sc = (float*)smem;
  float* red = sc + 9216;
  for (int i = tid; i < 9216; i += 256) {
    const int row = i >> 10, k = i & 1023;
    const float v = row == 0 ? p.c_ctx[k] : p.c[(row - 1) * 1024 + k];
    sc[i] = v / (1.f + expf(-v));
  }
  __syncthreads();
  const int col = tid & 63, kg = tid >> 6;
  const float* w = p.ada_w + (size_t)l * 1024 * 6144 + cb * 64 + col;
  float acc[9];
  UNROLL for (int r = 0; r < 9; ++r) acc[r] = 0.f;
  for (int k = kg * 256; k < kg * 256 + 256; ++k) {
    const float wv = w[(size_t)k * 6144];
    UNROLL for (int r = 0; r < 9; ++r) acc[r] += sc[r * 1024 + k] * wv;
  }
  UNROLL for (int r = 0; r < 9; ++r) red[(kg * 9 + r) * 64 + col] = acc[r];
  __syncthreads();
  if (kg == 0) {
    float* mod = (float*)(p.ws + OFF_MOD);
    UNROLL for (int r = 0; r < 9; ++r)
      mod[(size_t)(l * 9 + r) * 6144 + cb * 64 + col] =
          red[r * 64 + col] + red[(9 + r) * 64 + col] + red[(18 + r) * 64 + col] + red[(27 + r) * 64 + col] + p.ada_b[l * 6144 + cb * 64 + col];
  }
}

DI void rope_item(const Params& p) {
  float* tab = (float*)(p.ws + OFF_ROPE);
  for (int i = tid_(); i < 2048; i += 256) {
    const int pos = i >> 5, f = i & 31;
    const float inv = powf(10000.f, -(float)f / 32.f);
    const float ang = (float)pos * inv;
    tab[i] = cosf(ang); tab[2048 + i] = sinf(ang);
  }
}

template <int MODE>
DI void rowpass(const Params& p, int layer, int row) {
  const int lane = tid_() & 63;
  const int mr = row < TCTX ? 0 : 1 + ((row - TCTX) >> 12);
  float* xr = p.out + (size_t)row * 1024;
  bf* yr = (bf*)(p.ws + OFF_RX) + (size_t)row * 1024;
  const float* mod = (const float*)(p.ws + OFF_MOD);
  const int e0 = lane * 8;
  float x[16];
  {
    const float* src = xr;
    if (MODE == 0) src = row < TCTX ? p.x_prompt + (size_t)row * 1024 : p.x_sample + (size_t)(row - TCTX) * 1024;
    UNROLL for (int hh = 0; hh < 2; ++hh) UNROLL for (int v4 = 0; v4 < 2; ++v4) {
      const float4 v = *(const float4*)(src + hh * 512 + e0 + v4 * 4);
      x[hh * 8 + v4 * 4 + 0] = v.x; x[hh * 8 + v4 * 4 + 1] = v.y; x[hh * 8 + v4 * 4 + 2] = v.z; x[hh * 8 + v4 * 4 + 3] = v.w;
    }
  }
  if (MODE != 0) {
    float y[16];
    UNROLL for (int hh = 0; hh < 2; ++hh) { const bf16x8 v = *(const bf16x8*)(yr + hh * 512 + e0); unpack8(v, y + hh * 8); }
    float ss = 0.f;
    UNROLL for (int i = 0; i < 16; ++i) ss += y[i] * y[i];
    ss = wave_sum(ss);
    const float rstd = rsqrtf(ss * (1.f / 1024.f) + EPSF);
    const float* g = mod + (size_t)(layer * 9 + mr) * 6144 + (MODE == 1 ? 2048 : 5120);
    const float* wp = (MODE == 1 ? p.n_mix_post : p.n_mlp_post) + layer * 1024;
    UNROLL for (int hh = 0; hh < 2; ++hh) UNROLL for (int e = 0; e < 8; ++e) {
      const int c = hh * 512 + e0 + e;
      x[hh * 8 + e] += g[c] * (y[hh * 8 + e] * rstd * wp[c]);
    }
  }
  UNROLL for (int hh = 0; hh < 2; ++hh) UNROLL for (int v4 = 0; v4 < 2; ++v4)
    *(float4*)(xr + hh * 512 + e0 + v4 * 4) = make_float4(x[hh * 8 + v4 * 4], x[hh * 8 + v4 * 4 + 1], x[hh * 8 + v4 * 4 + 2], x[hh * 8 + v4 * 4 + 3]);
  if (MODE == 2 && layer == 3) return;
  const int nl = MODE == 2 ? layer + 1 : layer;
  const float* wpre = (MODE == 1 ? p.n_mlp_pre : p.n_mix_pre) + nl * 1024;
  const float* m2 = mod + (size_t)(nl * 9 + mr) * 6144;
  const float* sh = m2 + (MODE == 1 ? 3072 : 0);
  const float* sc = m2 + (MODE == 1 ? 4096 : 1024);
  float ss = 0.f;
  UNROLL for (int i = 0; i < 16; ++i) ss += x[i] * x[i];
  ss = wave_sum(ss);
  const float rstd = rsqrtf(ss * (1.f / 1024.f) + EPSF);
  UNROLL for (int hh = 0; hh < 2; ++hh) {
    bf16x8 o;
    UNROLL for (int e = 0; e < 8; ++e) {
      const int c = hh * 512 + e0 + e;
      o[e] = (short)f2bf(x[hh * 8 + e] * rstd * wpre[c] * (1.f + sc[c]) + sh[c]);
    }
    const int col = hh * 512 + e0;
    *(bf16x8*)((bf*)(p.ws + OFF_H) + ((size_t)(col >> 5) * TALL + row) * 32 + (col & 31)) = o;
  }
}

template <int EPI>
DI void gemm_tile(char* smem, const bf* A0, const bf* A1, int lda, int ksplit, const bf* Bt, int K, int m0, int n0,
                  bf* C, int ldc, float* gates) {
  const int tid = tid_(), lane = tid & 63, w = tid >> 6, r = lane & 15, q = lane >> 4;
  const int wm = w >> 1, wn = w & 1;
  const int lr = tid >> 3, c8 = (tid & 7) * 8;
  bf16x8 ra[4], rb[4];
  f32x4 acc[4][4];
  UNROLL for (int i = 0; i < 4; ++i) UNROLL for (int jn = 0; jn < 4; ++jn) acc[i][jn] = f32x4{0.f, 0.f, 0.f, 0.f};
  const int nk = K >> 6;
  {
    const bf* Ab = A0;
    UNROLL for (int i = 0; i < 4; ++i) {
      ra[i] = *(const bf16x8*)(Ab + (size_t)(m0 + lr + 32 * i) * lda + c8);
      rb[i] = *(const bf16x8*)(Bt + (size_t)(n0 + lr + 32 * i) * K + c8);
    }
    bf* As = (bf*)smem; bf* Bs = As + 128 * 72;
    UNROLL for (int i = 0; i < 4; ++i) { *(bf16x8*)(As + (lr + 32 * i) * 72 + c8) = ra[i]; *(bf16x8*)(Bs + (lr + 32 * i) * 72 + c8) = rb[i]; }
  }
  __syncthreads();
  for (int kt = 0; kt < nk; ++kt) {
    if (kt + 1 < nk) {
      const int k0 = (kt + 1) << 6;
      const bf* Ab = (k0 < ksplit) ? A0 + k0 : A1 + (k0 - ksplit);
      UNROLL for (int i = 0; i < 4; ++i) {
        ra[i] = *(const bf16x8*)(Ab + (size_t)(m0 + lr + 32 * i) * lda + c8);
        rb[i] = *(const bf16x8*)(Bt + (size_t)(n0 + lr + 32 * i) * K + k0 + c8);
      }
    }
    const bf* As = (const bf*)smem + (kt & 1) * (2 * 128 * 72); const bf* Bs = As + 128 * 72;
    UNROLL for (int ks = 0; ks < 2; ++ks) {
      bf16x8 af[4], bfr[4];
      UNROLL for (int i = 0; i < 4; ++i) {
        af[i]  = *(const bf16x8*)(As + (wm * 64 + i * 16 + r) * 72 + ks * 32 + q * 8);
        bfr[i] = *(const bf16x8*)(Bs + (wn * 64 + i * 16 + r) * 72 + ks * 32 + q * 8);
      }
      UNROLL for (int mi = 0; mi < 4; ++mi) UNROLL for (int ni = 0; ni < 4; ++ni) acc[mi][ni] = MFMA16(bfr[ni], af[mi], acc[mi][ni]);
    }
    if (kt + 1 < nk) {
      bf* Aw = (bf*)smem + ((kt + 1) & 1) * (2 * 128 * 72); bf* Bw = Aw + 128 * 72;
      UNROLL for (int i = 0; i < 4; ++i) { *(bf16x8*)(Aw + (lr + 32 * i) * 72 + c8) = ra[i]; *(bf16x8*)(Bw + (lr + 32 * i) * 72 + c8) = rb[i]; }
    }
    __syncthreads();
  }
  UNROLL for (int mi = 0; mi < 4; ++mi) UNROLL for (int ni = 0; ni < 4; ++ni) {
    const int m = m0 + wm * 64 + mi * 16 + r, n = n0 + wn * 64 + ni * 16 + q * 4;
    f32x4 v = acc[mi][ni];
    if (EPI == 0) {
      if (n < 3072) *(s16x4*)(C + (size_t)m * ldc + n) = pack4(v);
      else if (n < 3088) *(float4*)(gates + (size_t)m * 16 + (n - 3072)) = make_float4(v[0], v[1], v[2], v[3]);
    } else if (EPI == 1) {
      *(s16x4*)(C + (size_t)m * ldc + n) = pack4(v);
    } else {
      UNROLL for (int e = 0; e < 4; ++e) { const float t = fmaxf(v[e], 0.f); v[e] = t * t; }
      *(s16x4*)(C + (size_t)m * ldc + n) = pack4(v);
    }
  }
}

DI unsigned xcc_id() { return (unsigned)__builtin_amdgcn_s_getreg((3 << 11) | 20) & 0xFu; }
#define WAIT_VM(n) asm volatile("s_waitcnt vmcnt(" #n ")" ::: "memory")
template <int EPI, int VAR = 0, int BLK = 0>
DI void gemm_tile2(char* smem, const bf* A0, const bf* A1, int lda, int ksplit, const bf* Bt, int K, int m0, int n0,
                   bf* C, int ldc, float* gates) {
  const int tid = tid_(), lane = tid & 63, w = tid >> 6, r = lane & 15, q = lane >> 4;
  const int wm = w >> 1, wn = w & 1;
  const int lrow = lane >> 2, lseg = (lane & 3) * 8;
  f32x4 acc[4][4];
  UNROLL for (int i = 0; i < 4; ++i) UNROLL for (int jn = 0; jn < 4; ++jn) acc[i][jn] = f32x4{0.f, 0.f, 0.f, 0.f};
  const int nk = K >> 5;
  const unsigned sbase = (unsigned)(size_t)smem;
#define GEMM2_ISSUE(kt_)                                                                                              \
  {                                                                                                                   \
    const int k0_ = (kt_) << 5;                                                                                       \
    const bf* Ab_ = (k0_ < ksplit) ? A0 + k0_ : A1 + (k0_ - ksplit);                                                  \
    char* sb_ = smem + ((kt_) & 3) * 16384;                                                                           \
    UNROLL for (int i_ = 0; i_ < 2; ++i_) {                                                                           \
      const int c_ = i_ * 4 + w;                                                                                      \
      const bf* ga_ = BLK ? A0 + ((size_t)(kt_) * TALL + m0 + c_ * 16 + lrow) * 32 + lseg                              \
                          : Ab_ + (size_t)(m0 + c_ * 16 + lrow) * lda + lseg;                                         \
      const bf* gb_ = BLK ? Bt + ((size_t)(kt_) * 1024 + n0 + c_ * 16 + lrow) * 32 + lseg                              \
                          : Bt + (size_t)(n0 + c_ * 16 + lrow) * K + k0_ + lseg;                                      \
      __builtin_amdgcn_global_load_lds((const unsigned*)ga_, (unsigned*)(sb_ + c_ * 1024), 16, 0, 0);                 \
      __builtin_amdgcn_global_load_lds((const unsigned*)gb_, (unsigned*)(sb_ + 8192 + c_ * 1024), 16, 0, 0);          \
    }                                                                                                                 \
  }
  if (VAR != 2) { GEMM2_ISSUE(0) GEMM2_ISSUE(1) GEMM2_ISSUE(2) }
  for (int kt = 0; kt < nk; ++kt) {
    const int rem = nk - 1 - kt;
    if (rem >= 2) WAIT_VM(8); else if (rem == 1) WAIT_VM(4); else WAIT_VM(0);
    asm volatile("s_waitcnt lgkmcnt(0)" ::: "memory");
    __builtin_amdgcn_s_barrier();
    if (VAR != 2) { if (kt + 3 < nk) GEMM2_ISSUE(kt + 3) }
    if (VAR == 3) continue;
    bf16x8 af[4], bfr[4];
    {
      const unsigned sa = sbase + (kt & 3) * 16384 + (wm * 64 + r) * 64 + q * 16;
      const unsigned sb = sbase + (kt & 3) * 16384 + 8192 + (wn * 64 + r) * 64 + q * 16;
      asm volatile(
          "ds_read_b128 %0, %8\n\tds_read_b128 %1, %8 offset:1024\n\tds_read_b128 %2, %8 offset:2048\n\tds_read_b128 %3, %8 offset:3072\n\t"
          "ds_read_b128 %4, %9\n\tds_read_b128 %5, %9 offset:1024\n\tds_read_b128 %6, %9 offset:2048\n\tds_read_b128 %7, %9 offset:3072\n\t"
          "s_waitcnt lgkmcnt(0)"
          : "=&v"(af[0]), "=&v"(af[1]), "=&v"(af[2]), "=&v"(af[3]), "=&v"(bfr[0]), "=&v"(bfr[1]), "=&v"(bfr[2]), "=&v"(bfr[3])
          : "v"(sa), "v"(sb)
          : "memory");
    }
    UNROLL for (int mi = 0; mi < 4; ++mi) UNROLL for (int ni = 0; ni < 4; ++ni) acc[mi][ni] = MFMA16(bfr[ni], af[mi], acc[mi][ni]);
  }
#undef GEMM2_ISSUE
  if (VAR != 0) {
    float t = 0.f;
    UNROLL for (int mi = 0; mi < 4; ++mi) UNROLL for (int ni = 0; ni < 4; ++ni) t += acc[mi][ni][0] + acc[mi][ni][1] + acc[mi][ni][2] + acc[mi][ni][3];
    if (t == 12345.678f) gates[tid] = t;
    return;
  }
  UNROLL for (int mi = 0; mi < 4; ++mi) UNROLL for (int ni = 0; ni < 4; ++ni) {
    const int m = m0 + wm * 64 + mi * 16 + r, n = n0 + wn * 64 + ni * 16 + q * 4;
    f32x4 v = acc[mi][ni];
    if (EPI == 0) {
      if (n < 3072) *(s16x4*)(C + (size_t)m * ldc + n) = pack4(v);
      else if (n < 3088) *(float4*)(gates + (size_t)m * 16 + (n - 3072)) = make_float4(v[0], v[1], v[2], v[3]);
    } else if (EPI == 1) {
      *(s16x4*)(C + (size_t)m * ldc + n) = pack4(v);
    } else {
      UNROLL for (int e = 0; e < 4; ++e) { const float t = fmaxf(v[e], 0.f); v[e] = t * t; }
      *(s16x4*)(C + (size_t)m * ldc + n) = pack4(v);
    }
  }
}

DI void gates_tile(const bf* H, const bf* Wb, int m0, float* gates) {
  const int tid = tid512_(), lane = tid & 63, w = tid >> 6, r = lane & 15, q = lane >> 4;
  f32x4 acc0 = f32x4{0.f, 0.f, 0.f, 0.f}, acc1 = f32x4{0.f, 0.f, 0.f, 0.f};
  const bf* a0p = H + (size_t)(m0 + w * 32 + r) * 32 + q * 8;
  const bf* a1p = a0p + 16 * 32;
  const bf* bp = Wb + (size_t)(3072 + r) * 32 + q * 8;
  _Pragma("unroll 4") for (int ks = 0; ks < 32; ++ks) {
    const bf16x8 b = *(const bf16x8*)(bp + (size_t)ks * 3200 * 32);
    acc0 = MFMA16(b, *(const bf16x8*)(a0p + (size_t)ks * TALL * 32), acc0);
    acc1 = MFMA16(b, *(const bf16x8*)(a1p + (size_t)ks * TALL * 32), acc1);
  }
  *(float4*)(gates + (size_t)(m0 + w * 32 + r) * 16 + q * 4) = make_float4(acc0[0], acc0[1], acc0[2], acc0[3]);
  *(float4*)(gates + (size_t)(m0 + w * 32 + 16 + r) * 16 + q * 4) = make_float4(acc1[0], acc1[1], acc1[2], acc1[3]);
}

template <int EPI>
DI void gemm_tile3(char* smem, const bf* A, const bf* Bt, int nrows, int K, int m0, int n0, bf* C, int ldc) {
  const int tid = tid_(), lane = tid & 63, w = tid >> 6, r = lane & 15, q = lane >> 4;
  const int wm = w >> 1, wn = w & 1;
  const int lrow = lane >> 2, lseg = (lane & 3) * 8;
  f32x4 acc[8][4];
  UNROLL for (int i = 0; i < 8; ++i) UNROLL for (int jn = 0; jn < 4; ++jn) acc[i][jn] = f32x4{0.f, 0.f, 0.f, 0.f};
  const int nk = K >> 5;
  const unsigned sbase = (unsigned)(size_t)smem;
#define GEMM3_ISSUE(kt_)                                                                                              \
  {                                                                                                                   \
    const int k0_ = (kt_) << 5;                                                                                       \
    char* sb_ = smem + ((kt_) % 3) * 24576;                                                                           \
    UNROLL for (int i_ = 0; i_ < 4; ++i_) {                                                                           \
      const int c_ = i_ * 4 + w;                                                                                      \
      __builtin_amdgcn_global_load_lds((const unsigned*)(A + ((size_t)(kt_) * TALL + m0 + c_ * 16 + lrow) * 32 + lseg),    \
                                       (unsigned*)(sb_ + c_ * 1024), 16, 0, 0);                                       \
    }                                                                                                                 \
    UNROLL for (int i_ = 0; i_ < 2; ++i_) {                                                                           \
      const int c_ = i_ * 4 + w;                                                                                      \
      __builtin_amdgcn_global_load_lds((const unsigned*)(Bt + ((size_t)(kt_) * nrows + n0 + c_ * 16 + lrow) * 32 + lseg),  \
                                       (unsigned*)(sb_ + 16384 + c_ * 1024), 16, 0, 0);                               \
    }                                                                                                                 \
  }
  GEMM3_ISSUE(0) GEMM3_ISSUE(1)
  int slot = 0;
  for (int kt = 0; kt < nk; ++kt) {
    if (kt + 1 < nk) WAIT_VM(6); else WAIT_VM(0);
    asm volatile("s_waitcnt lgkmcnt(0)" ::: "memory");
    __builtin_amdgcn_s_barrier();
    if (kt + 2 < nk) GEMM3_ISSUE(kt + 2)
    bf16x8 af[8], bfr[4];
    {
      const unsigned sa = sbase + slot * 24576 + (wm * 128 + r) * 64 + q * 16;
      const unsigned sb = sbase + slot * 24576 + 16384 + (wn * 64 + r) * 64 + q * 16;
      asm volatile(
          "ds_read_b128 %0, %13\n\tds_read_b128 %1, %13 offset:1024\n\tds_read_b128 %2, %13 offset:2048\n\tds_read_b128 %3, %13 offset:3072\n\t"
          "ds_read_b128 %4, %12\n\tds_read_b128 %5, %12 offset:1024\n\tds_read_b128 %6, %12 offset:2048\n\tds_read_b128 %7, %12 offset:3072\n\t"
          "ds_read_b128 %8, %12 offset:4096\n\tds_read_b128 %9, %12 offset:5120\n\tds_read_b128 %10, %12 offset:6144\n\tds_read_b128 %11, %12 offset:7168\n\t"
          "s_waitcnt lgkmcnt(4)"
          : "=&v"(bfr[0]), "=&v"(bfr[1]), "=&v"(bfr[2]), "=&v"(bfr[3]), "=&v"(af[0]), "=&v"(af[1]), "=&v"(af[2]), "=&v"(af[3]),
            "=&v"(af[4]), "=&v"(af[5]), "=&v"(af[6]), "=&v"(af[7])
          : "v"(sa), "v"(sb)
          : "memory");
    }
    UNROLL for (int mi = 0; mi < 4; ++mi) UNROLL for (int ni = 0; ni < 4; ++ni) acc[mi][ni] = MFMA16(bfr[ni], af[mi], acc[mi][ni]);
    asm volatile("s_waitcnt lgkmcnt(0)" : "+v"(af[4]), "+v"(af[5]), "+v"(af[6]), "+v"(af[7]) : : "memory");
    UNROLL for (int mi = 4; mi < 8; ++mi) UNROLL for (int ni = 0; ni < 4; ++ni) acc[mi][ni] = MFMA16(bfr[ni], af[mi], acc[mi][ni]);
    slot = slot == 2 ? 0 : slot + 1;
  }
#undef GEMM3_ISSUE
  UNROLL for (int mi = 0; mi < 8; ++mi) UNROLL for (int ni = 0; ni < 4; ++ni) {
    const int m = m0 + wm * 128 + mi * 16 + r, n = n0 + wn * 64 + ni * 16 + q * 4;
    f32x4 v = acc[mi][ni];
    if (EPI == 2) {
      UNROLL for (int e = 0; e < 4; ++e) { const float t = fmaxf(v[e], 0.f); v[e] = t * t; }
      *(s16x4*)(C + ((size_t)(n >> 5) * TALL + m) * 32 + (n & 31)) = pack4(v);
    } else {
      *(s16x4*)(C + (size_t)m * ldc + n) = pack4(v);
    }
  }
}

#define LDS_RD(D, ADDR, OFF) asm volatile("ds_read_b128 %0, %1 offset:" #OFF : "=v"(D) : "v"(ADDR) : "memory")
template <int BN, int EPI, int AMODE, int BMODE, int VAR = 0>
DI void gemm512(char* smem, const bf* A0, const bf* A1, int lda, int ksplit, const bf* Bt, int nrows, int K, int m0, int n0, bf* C, int ldc) {
  constexpr int MI = BN == 256 ? 8 : 4;
  constexpr int STAGE = BN == 256 ? 32768 : 24576;
  constexpr int NSLOT = BN == 256 ? 4 : 6;
  constexpr int PER = BN == 256 ? 4 : 3;
  const int tid = tid512_(), lane = tid & 63, w = tid >> 6, r = lane & 15, q = lane >> 4;
  const int wm = BN == 256 ? (w >> 2) : (w >> 1), wn = BN == 256 ? (w & 3) : (w & 1);
  const int lrow = lane >> 2, lseg = ((lane & 3) ^ ((0x78 >> (2 * (lane >> 4))) & 3)) * 8;
  f32x4 acc[MI][4];
  UNROLL for (int i = 0; i < MI; ++i) UNROLL for (int jn = 0; jn < 4; ++jn) acc[i][jn] = f32x4{0.f, 0.f, 0.f, 0.f};
  const int nk = K >> 5;
  const unsigned sbase = (unsigned)(size_t)smem;
  const unsigned rsw = (unsigned)((q ^ ((0x78 >> (2 * (r >> 2))) & 3)) * 16);
  const unsigned offa = (wm * (MI * 16) + r) * 64 + rsw, offb = 16384 + (wn * 64 + r) * 64 + rsw;
#define G5_ISSUE(kt_, slot_)                                                                                          \
  {                                                                                                                   \
    const int k0_ = (kt_) << 5;                                                                                       \
    char* sb_ = smem + (slot_) * STAGE;                                                                               \
    const bf* Ab_ = (k0_ < ksplit) ? A0 + k0_ : A1 + (k0_ - ksplit);                                                  \
    UNROLL for (int i_ = 0; i_ < 2; ++i_) {                                                                           \
      const int c_ = i_ * 8 + w;                                                                                      \
      const bf* ga_ = AMODE ? A0 + ((size_t)(kt_) * TALL + m0 + c_ * 16 + lrow) * 32 + lseg                            \
                            : Ab_ + (size_t)(m0 + c_ * 16 + lrow) * lda + lseg;                                       \
      __builtin_amdgcn_global_load_lds((const unsigned*)ga_, (unsigned*)(sb_ + c_ * 1024), 16, 0, 0);                 \
    }                                                                                                                 \
    UNROLL for (int i_ = 0; i_ < BN / 128; ++i_) {                                                                    \
      const int c_ = i_ * 8 + w;                                                                                      \
      const bf* gb_ = BMODE ? Bt + ((size_t)(kt_) * nrows + n0 + c_ * 16 + lrow) * 32 + lseg                           \
                            : Bt + (size_t)(n0 + c_ * 16 + lrow) * K + k0_ + lseg;                                    \
      __builtin_amdgcn_global_load_lds((const unsigned*)gb_, (unsigned*)(sb_ + 16384 + c_ * 1024), 16, 0, 0);         \
    }                                                                                                                 \
  }
#define G5_WAIT_TILES(n_)                                                                                             \
  {                                                                                                                   \
    const int nt_ = (n_);                                                                                             \
    if (PER == 4) { if (nt_ >= 3) WAIT_VM(12); else if (nt_ == 2) WAIT_VM(8); else if (nt_ == 1) WAIT_VM(4); else WAIT_VM(0); } \
    else { if (nt_ >= 5) WAIT_VM(15); else if (nt_ == 4) WAIT_VM(12); else if (nt_ == 3) WAIT_VM(9); else if (nt_ == 2) WAIT_VM(6); \
           else if (nt_ == 1) WAIT_VM(3); else WAIT_VM(0); }                                                          \
  }
  constexpr int AH = MI / 2;
  bf16x8 bc[4], bn[4], ax[AH], ay[AH];
  if (VAR != 2) { UNROLL for (int s = 0; s < NSLOT; ++s) G5_ISSUE(s, s) }
  G5_WAIT_TILES(NSLOT - 1)
  __builtin_amdgcn_s_barrier();
#define G5_RD_LO(BB, AA, SA, SB)                                                                                      \
  {                                                                                                                   \
    LDS_RD(BB[0], SB, 0); LDS_RD(BB[1], SB, 1024); LDS_RD(BB[2], SB, 2048); LDS_RD(BB[3], SB, 3072);                  \
    LDS_RD(AA[0], SA, 0); LDS_RD(AA[1], SA, 1024);                                                                    \
    if constexpr (AH == 4) { LDS_RD(AA[AH - 2], SA, 2048); LDS_RD(AA[AH - 1], SA, 3072); }                            \
  }
#define G5_RD_HI(AA, SA)                                                                                              \
  {                                                                                                                   \
    if constexpr (AH == 4) { LDS_RD(AA[0], SA, 4096); LDS_RD(AA[1], SA, 5120); LDS_RD(AA[AH - 2], SA, 6144); LDS_RD(AA[AH - 1], SA, 7168); } \
    else { LDS_RD(AA[0], SA, 2048); LDS_RD(AA[1], SA, 3072); }                                                        \
  }
#define G5_LGKM0_A(AA)                                                                                                \
  {                                                                                                                   \
    if constexpr (AH == 4) asm volatile("s_waitcnt lgkmcnt(0)" : "+v"(AA[0]), "+v"(AA[1]), "+v"(AA[2]), "+v"(AA[3]) : : "memory"); \
    else asm volatile("s_waitcnt lgkmcnt(0)" : "+v"(AA[0]), "+v"(AA[1]) : : "memory");                                \
  }
#define G5_LGKM0_BA(BB, AA)                                                                                           \
  {                                                                                                                   \
    if constexpr (AH == 4) asm volatile("s_waitcnt lgkmcnt(0)" : "+v"(BB[0]), "+v"(BB[1]), "+v"(BB[2]), "+v"(BB[3]), "+v"(AA[0]), "+v"(AA[1]), "+v"(AA[2]), "+v"(AA[3]) : : "memory"); \
    else asm volatile("s_waitcnt lgkmcnt(0)" : "+v"(BB[0]), "+v"(BB[1]), "+v"(BB[2]), "+v"(BB[3]), "+v"(AA[0]), "+v"(AA[1]) : : "memory"); \
  }
  {
    const unsigned sa = sbase + offa, sb = sbase + offb;
    G5_RD_LO(bc, ax, sa, sb)
    G5_LGKM0_BA(bc, ax)
  }
  int cslot = 0;
#define G5_STEP(BC, BN_)                                                                                              \
  {                                                                                                                   \
    {                                                                                                                 \
      const unsigned sa = sbase + cslot * STAGE + offa;                                                               \
      G5_RD_HI(ay, sa)                                                                                                \
    }                                                                                                                 \
    if (VAR != 3) { UNROLL for (int mi = 0; mi < AH; ++mi) UNROLL for (int ni = 0; ni < 4; ++ni) acc[mi][ni] = MFMA16(BC[ni], ax[mi], acc[mi][ni]); } \
    G5_LGKM0_A(ay)                                                                                                    \
    if (kt + 1 < nk) { const int t_ = nk - 2 - kt; G5_WAIT_TILES(t_ < NSLOT - 2 ? t_ : NSLOT - 2) }                   \
    __builtin_amdgcn_s_barrier();                                                                                     \
    if (VAR != 2) { if (kt + NSLOT < nk) G5_ISSUE(kt + NSLOT, cslot) }                                                \
    cslot = cslot == NSLOT - 1 ? 0 : cslot + 1;                                                                       \
    if (kt + 1 < nk) {                                                                                                \
      const unsigned sa = sbase + cslot * STAGE + offa, sb = sbase + cslot * STAGE + offb;                            \
      G5_RD_LO(BN_, ax, sa, sb)                                                                                       \
    }                                                                                                                 \
    if (VAR != 3) { UNROLL for (int mi = 0; mi < AH; ++mi) UNROLL for (int ni = 0; ni < 4; ++ni) acc[AH + mi][ni] = MFMA16(BC[ni], ay[mi], acc[AH + mi][ni]); } \
    G5_LGKM0_BA(BN_, ax)                                                                                              \
    ++kt;                                                                                                             \
  }
  for (int kt = 0; kt < nk;) {
    G5_STEP(bc, bn)
    G5_STEP(bn, bc)
  }
#undef G5_STEP
#undef G5_RD_LO
#undef G5_RD_HI
#undef G5_LGKM0_A
#undef G5_LGKM0_BA
#undef G5_ISSUE
#undef G5_WAIT_TILES
  if (VAR != 0) {
    float t = 0.f;
    UNROLL for (int mi = 0; mi < MI; ++mi) UNROLL for (int ni = 0; ni < 4; ++ni) t += acc[mi][ni][0] + acc[mi][ni][1] + acc[mi][ni][2] + acc[mi][ni][3];
    if (t == 12345.678f) C[tid] = (bf)1;
    return;
  }
  UNROLL for (int mi = 0; mi < MI; ++mi) UNROLL for (int ni = 0; ni < 4; ++ni) {
    const int m = m0 + wm * (MI * 16) + mi * 16 + r, n = n0 + wn * 64 + ni * 16 + q * 4;
    f32x4 v = acc[mi][ni];
    if (EPI == 2) {
      UNROLL for (int e = 0; e < 4; ++e) { const float t = fmaxf(v[e], 0.f); v[e] = t * t; }
      *(s16x4*)(C + ((size_t)(n >> 5) * TALL + m) * 32 + (n & 31)) = pack4(v);
    } else {
      *(s16x4*)(C + (size_t)m * ldc + n) = pack4(v);
    }
  }
}

DI void conv_item(const Params& p, int layer, int item) {
  const bool even = !(layer & 1); const int j = layer >> 1;
  const int tid = tid_(), lane = tid & 63, w = tid >> 6;
  const bf* P = (const bf*)(p.ws + OFF_P);
  bf* X = (bf*)(p.ws + OFF_RX);
  for (int tt = 0; tt < 4; ++tt) {
    const int tok = item * 16 + w * 4 + tt;
    int L, pos;
    if (tok < TCTX) { L = 256; pos = tok & 255; } else { L = 4096; pos = (tok - TCTX) & 4095; }
    const bool hp = pos > 0, hn = pos < L - 1;
    const bf* pr = P + (size_t)tok * PLD;
    if (even) {
      const float* cw = p.gdn_conv + (size_t)j * 3 * 1536;
      for (int g = 0; g < 12; ++g) {
        const int c = g * 128 + lane * 2;
        const unsigned ua = hp ? *(const unsigned*)(pr - PLD + c) : 0u;
        const unsigned ub = *(const unsigned*)(pr + c);
        const unsigned uc = hn ? *(const unsigned*)(pr + PLD + c) : 0u;
        const float2 w0 = *(const float2*)(cw + c), w1 = *(const float2*)(cw + 1536 + c), w2 = *(const float2*)(cw + 3072 + c);
        float v0 = bflo(ua) * w0.x + bflo(ub) * w1.x + bflo(uc) * w2.x;
        float v1 = bfhi(ua) * w0.y + bfhi(ub) * w1.y + bfhi(uc) * w2.y;
        v0 = silu(v0); v1 = silu(v1);
        if (g < 8) {
          const float ss = wave_sum(v0 * v0 + v1 * v1);
          float sc = rsqrtf(ss + EPSF);
          if (g < 4) sc *= 0.08838834764831845f;
          v0 *= sc; v1 *= sc;
        }
        *(unsigned*)(X + (size_t)tok * 1536 + c) = packbf(v0, v1);
      }
    } else {
      const float* cw = p.ssd_conv + (size_t)j * 3 * 1024;
      const float* cb = p.ssd_conv_b + (size_t)j * 1024;
      for (int g = 0; g < 8; ++g) {
        const int c = g * 128 + lane * 2;
        const unsigned ua = hp ? *(const unsigned*)(pr - PLD + 512 + c) : 0u;
        const unsigned ub = *(const unsigned*)(pr + 512 + c);
        const unsigned uc = hn ? *(const unsigned*)(pr + PLD + 512 + c) : 0u;
        const float2 w0 = *(const float2*)(cw + c), w1 = *(const float2*)(cw + 1024 + c), w2 = *(const float2*)(cw + 2048 + c);
        const float2 bb = *(const float2*)(cb + c);
        float v0 = bflo(ua) * w0.x + bflo(ub) * w1.x + bflo(uc) * w2.x + bb.x;
        float v1 = bfhi(ua) * w0.y + bfhi(ub) * w1.y + bfhi(uc) * w2.y + bb.y;
        *(unsigned*)(X + (size_t)tok * 1024 + c) = packbf(silu(v0), silu(v1));
      }
    }
  }
  {
    const int tok = item * 16 + (tid >> 4), gi = tid & 15;
    const float gv = ((const float*)(p.ws + OFF_GATES))[(size_t)tok * 16 + gi];
    float o;
    if (even) {
      if (gi < 8) o = 1.f / (1.f + expf(-gv));
      else o = -expf(p.gdn_alog[j * 8 + gi - 8]) * softplus(gv + p.gdn_dtb[j * 8 + gi - 8]);
    } else {
      o = softplus(gv + p.ssd_dtb[j * 16 + gi]);
    }
    ((float*)(p.ws + OFF_BG))[(size_t)tok * 16 + gi] = o;
  }
}

DI void kvprep_item(char* smem, const Params& p, int layer, int item) {
  const bool even = !(layer & 1); const int j = layer >> 1; const int nH = even ? 2 : 4;
  const int tid = tid_();
  const int nctx = 16 * nH * 4;
  const bool ctx = item < nctx;
  int seq, kvh, tile, S;
  if (ctx) { seq = item / (nH * 4); kvh = (item >> 2) % nH; tile = item & 3; S = 256; }
  else { const int it = item - nctx; seq = it / (nH * 72); kvh = (it / 72) % nH; tile = it % 72; S = 4608; }
  const size_t slot = ctx ? (size_t)(seq * nH + kvh) * 256 * 128 : (size_t)16 * nH * 256 * 128 + (size_t)(seq * nH + kvh) * 4608 * 128;
  bf* Kd = (bf*)(p.ws + OFF_KB) + slot;
  bf* Vd = (bf*)(p.ws + OFF_VT) + slot;
  const int r = tid >> 2, pp = tid & 3;
  const int key = tile * 64 + r;
  const bool fromP = ctx || tile < 64;
  float kx[32], vx[32];
  if (fromP) {
    const int tok = ctx ? seq * 256 + key : TCTX + seq * 4096 + key;
    const bf* pr = (const bf*)(p.ws + OFF_P) + (size_t)tok * PLD;
    const int kcol = (even ? 2560 : 2048) + kvh * 128, vcol = (even ? 2816 : 2560) + kvh * 128;
    UNROLL for (int m = 0; m < 4; ++m) {
      unpack8(*(const bf16x8*)(pr + kcol + pp * 8 + 32 * m), kx + m * 8);
      unpack8(*(const bf16x8*)(pr + vcol + pp * 8 + 32 * m), vx + m * 8);
    }
  } else {
    const int ck = key - 4096;
    const float* ksrc = (even ? p.cgk : p.cnk) + ((size_t)((seq * 2 + j) * 512 + ck) * nH + kvh) * 128;
    const float* vsrc = (even ? p.cgv : p.cnv) + ((size_t)((seq * 2 + j) * 512 + ck) * nH + kvh) * 128;
    UNROLL for (int m = 0; m < 4; ++m) UNROLL for (int v4 = 0; v4 < 2; ++v4) {
      const float4 a = *(const float4*)(ksrc + pp * 8 + 32 * m + v4 * 4);
      const float4 b = *(const float4*)(vsrc + pp * 8 + 32 * m + v4 * 4);
      kx[m * 8 + v4 * 4] = a.x; kx[m * 8 + v4 * 4 + 1] = a.y; kx[m * 8 + v4 * 4 + 2] = a.z; kx[m * 8 + v4 * 4 + 3] = a.w;
      vx[m * 8 + v4 * 4] = b.x; vx[m * 8 + v4 * 4 + 1] = b.y; vx[m * 8 + v4 * 4 + 2] = b.z; vx[m * 8 + v4 * 4 + 3] = b.w;
    }
  }
  if (even && fromP) {
    float ss = 0.f;
    UNROLL for (int i = 0; i < 32; ++i) ss += kx[i] * kx[i];
    ss += __shfl_xor(ss, 1); ss += __shfl_xor(ss, 2);
    const float rstd = rsqrtf(ss * (1.f / 128.f) + EPSF);
    const float* kn = p.k_norm + j * 128;
    UNROLL for (int m = 0; m < 4; ++m) UNROLL for (int e = 0; e < 8; ++e) kx[m * 8 + e] *= rstd * kn[pp * 8 + 32 * m + e];
  }
  if (ctx) {
    float* ko = p.out + (even ? OUT_GK : OUT_NK) + ((size_t)((seq * 2 + j) * 256 + key) * nH + kvh) * 128;
    float* vo = p.out + (even ? OUT_GV : OUT_NV) + ((size_t)((seq * 2 + j) * 256 + key) * nH + kvh) * 128;
    UNROLL for (int m = 0; m < 4; ++m) UNROLL for (int v4 = 0; v4 < 2; ++v4) {
      *(float4*)(ko + pp * 8 + 32 * m + v4 * 4) = make_float4(kx[m * 8 + v4 * 4], kx[m * 8 + v4 * 4 + 1], kx[m * 8 + v4 * 4 + 2], kx[m * 8 + v4 * 4 + 3]);
      *(float4*)(vo + pp * 8 + 32 * m + v4 * 4) = make_float4(vx[m * 8 + v4 * 4], vx[m * 8 + v4 * 4 + 1], vx[m * 8 + v4 * 4 + 2], vx[m * 8 + v4 * 4 + 3]);
    }
  } else if (even && fromP) {
    const float* tab = (const float*)(p.ws + OFF_ROPE);
    const int prow = key >> 6, pcol = key & 63;
    UNROLL for (int e = 0; e < 8; ++e) {
      const int f = pp * 8 + e;
      float c = tab[prow * 32 + f], s = tab[2048 + prow * 32 + f];
      float x1 = kx[e], x2 = kx[8 + e];
      kx[e] = x1 * c - x2 * s; kx[8 + e] = x2 * c + x1 * s;
      c = tab[pcol * 32 + f]; s = tab[2048 + pcol * 32 + f];
      x1 = kx[16 + e]; x2 = kx[24 + e];
      kx[16 + e] = x1 * c - x2 * s; kx[24 + e] = x2 * c + x1 * s;
    }
  }
  bf* vt = (bf*)smem;
  UNROLL for (int m = 0; m < 4; ++m) {
    bf16x8 ko, vv;
    UNROLL for (int e = 0; e < 8; ++e) { ko[e] = (short)f2bf(kx[m * 8 + e]); vv[e] = (short)f2bf(vx[m * 8 + e]); }
    *(bf16x8*)(Kd + (size_t)key * 128 + pp * 8 + 32 * m) = ko;
    *(bf16x8*)(vt + r * 136 + pp * 8 + 32 * m) = vv;
  }
  __syncthreads();
  {
    const int d = tid >> 1, half = tid & 1;
    UNROLL for (int i = 0; i < 4; ++i) {
      bf16x8 o;
      UNROLL for (int e = 0; e < 8; ++e) o[e] = (short)vt[(half * 32 + i * 8 + e) * 136 + d];
      *(bf16x8*)(Vd + (size_t)d * S + tile * 64 + half * 32 + i * 8) = o;
    }
  }
}

DI void qprep_item(const Params& p, int layer, int item) {
  const int j = layer >> 1, tid = tid_();
  const int tile = item >> 2, h = item & 3;
  const int r = tid >> 2, pp = tid & 3;
  const int tok = tile * 64 + r;
  bf* pr = (bf*)(p.ws + OFF_P) + (size_t)tok * PLD + 2048 + h * 128;
  float qx[32];
  UNROLL for (int m = 0; m < 4; ++m) unpack8(*(const bf16x8*)(pr + pp * 8 + 32 * m), qx + m * 8);
  float ss = 0.f;
  UNROLL for (int i = 0; i < 32; ++i) ss += qx[i] * qx[i];
  ss += __shfl_xor(ss, 1); ss += __shfl_xor(ss, 2);
  const float rstd = rsqrtf(ss * (1.f / 128.f) + EPSF);
  const float* qn = p.q_norm + j * 128;
  UNROLL for (int m = 0; m < 4; ++m) UNROLL for (int e = 0; e < 8; ++e) qx[m * 8 + e] *= rstd * qn[pp * 8 + 32 * m + e];
  if (tok >= TCTX) {
    const float* tab = (const float*)(p.ws + OFF_ROPE);
    const int pos = (tok - TCTX) & 4095, prow = pos >> 6, pcol = pos & 63;
    UNROLL for (int e = 0; e < 8; ++e) {
      const int f = pp * 8 + e;
      float c = tab[prow * 32 + f], s = tab[2048 + prow * 32 + f];
      float x1 = qx[e], x2 = qx[8 + e];
      qx[e] = x1 * c - x2 * s; qx[8 + e] = x2 * c + x1 * s;
      c = tab[pcol * 32 + f]; s = tab[2048 + pcol * 32 + f];
      x1 = qx[16 + e]; x2 = qx[24 + e];
      qx[16 + e] = x1 * c - x2 * s; qx[24 + e] = x2 * c + x1 * s;
    }
  }
  UNROLL for (int m = 0; m < 4; ++m) {
    bf16x8 o;
    UNROLL for (int e = 0; e < 8; ++e) o[e] = (short)f2bf(qx[m * 8 + e]);
    *(bf16x8*)(pr + pp * 8 + 32 * m) = o;
  }
}

template <int QT, int MODE>
DI void attn_tile(char* smem, bf* Q, int ooff, const bf* Kb, const bf* Vt, int S, int ntiles, int r0, int qrow, const float* rpb) {
  const int tid = tid_(), lane = tid & 63, w = tid >> 6, r = lane & 15, q = lane >> 4;
  const float LOG2E = 1.4426950408889634f;
  int* hbar = (int*)(smem + SMEM_BYTES - 16); int hgen = 0;
  const unsigned sbase = (unsigned)(size_t)smem;
  if (tid == 0) *hbar = 0;
  const float cs = 0.08838834764831845f * LOG2E;
  bf16x8 qf[QT][4];
  UNROLL for (int qt = 0; qt < QT; ++qt) UNROLL for (int ks = 0; ks < 4; ++ks)
    qf[qt][ks] = *(const bf16x8*)(Q + (size_t)(w * 16 * QT + qt * 16 + r) * PLD + ks * 32 + q * 8);
  f32x4 o[8][QT];
  float mrow[QT], lrow[QT];
  UNROLL for (int qt = 0; qt < QT; ++qt) { mrow[qt] = -INFINITY; lrow[qt] = 0.f; UNROLL for (int dt = 0; dt < 8; ++dt) o[dt][qt] = f32x4{0.f, 0.f, 0.f, 0.f}; }
  const int krow = tid >> 2, kseg = tid & 3, vrow = tid >> 1, vhalf = tid & 1;
  bf16x8 kr_[4], vr_[4];
  {
    const int ko = MODE == 1 ? r0 * 64 : 0;
    UNROLL for (int i = 0; i < 4; ++i) {
      kr_[i] = *(const bf16x8*)(Kb + (size_t)(ko + krow) * 128 + kseg * 32 + i * 8);
      vr_[i] = *(const bf16x8*)(Vt + (size_t)vrow * S + ko + vhalf * 32 + i * 8);
    }
    bf* Ks = (bf*)smem; bf* Vs = Ks + 64 * 136;
    UNROLL for (int i = 0; i < 4; ++i) { *(bf16x8*)(Ks + krow * 136 + kseg * 32 + i * 8) = kr_[i]; *(bf16x8*)(Vs + vrow * 72 + vhalf * 32 + i * 8) = vr_[i]; }
  }
  __syncthreads();
  for (int it = 0; it < ntiles; ++it) {
    if (it + 1 < ntiles) {
      const int nx = it + 1;
      const int ko = MODE == 1 ? (nx < 8 ? (r0 + nx) * 64 : 4096 + (nx - 8) * 64) : nx * 64;
      UNROLL for (int i = 0; i < 4; ++i) {
        kr_[i] = *(const bf16x8*)(Kb + (size_t)(ko + krow) * 128 + kseg * 32 + i * 8);
        vr_[i] = *(const bf16x8*)(Vt + (size_t)vrow * S + ko + vhalf * 32 + i * 8);
      }
    }
    const bf* Ks = (const bf*)smem + (it & 1) * 17920; const bf* Vs = Ks + 64 * 136;
    f32x4 s[4][QT];
    {
      const unsigned kad = sbase + (it & 1) * 35840 + r * 272 + q * 16;
      bf16x8 ka0[4], ka1[4];
#define AT_RDK(KA, O0, O1, O2, O3) { LDS_RD(KA[0], kad, O0); LDS_RD(KA[1], kad, O1); LDS_RD(KA[2], kad, O2); LDS_RD(KA[3], kad, O3); }
#define AT_WAITK(N, KA) asm volatile("s_waitcnt lgkmcnt(" #N ")" : "+v"(KA[0]), "+v"(KA[1]), "+v"(KA[2]), "+v"(KA[3]) : : "memory")
#define AT_MMK(KT, KA)                                                                        \
      UNROLL for (int qt = 0; qt < QT; ++qt) {                                                \
        f32x4 a_ = f32x4{0.f, 0.f, 0.f, 0.f};                                                 \
        UNROLL for (int ks = 0; ks < 4; ++ks) a_ = MFMA16(KA[ks], qf[qt][ks], a_);            \
        s[KT][qt] = a_;                                                                       \
      }
      AT_RDK(ka0, 0, 64, 128, 192)
      AT_RDK(ka1, 4352, 4416, 4480, 4544)
      AT_WAITK(4, ka0);
      AT_MMK(0, ka0)
      AT_RDK(ka0, 8704, 8768, 8832, 8896)
      AT_WAITK(4, ka1);
      AT_MMK(1, ka1)
      AT_RDK(ka1, 13056, 13120, 13184, 13248)
      AT_WAITK(4, ka0);
      AT_MMK(2, ka0)
      AT_WAITK(0, ka1);
      AT_MMK(3, ka1)
#undef AT_RDK
#undef AT_WAITK
#undef AT_MMK
    }
    UNROLL for (int qt = 0; qt < QT; ++qt) {
      float mn, alpha, ls = 0.f;
      if (MODE == 1 && it < 8) {
        UNROLL for (int kt = 0; kt < 4; ++kt) UNROLL for (int jj = 0; jj < 4; ++jj) {
          const int qc = w * 16 + r, kc = kt * 16 + q * 4 + jj;
          int c0 = qc - 8; c0 = c0 < 0 ? 0 : (c0 > 48 ? 48 : c0);
          const bool valid = kc >= c0 && kc < c0 + 16;
          const int ro = r0 + it - qrow + 7; int co = kc - qc + 15; co = co < 0 ? 0 : (co > 30 ? 30 : co);
          s[kt][qt][jj] = valid ? s[kt][qt][jj] * cs + rpb[ro * 31 + co] * LOG2E : -INFINITY;
        }
        float mx = -INFINITY;
        UNROLL for (int kt = 0; kt < 4; ++kt) UNROLL for (int jj = 0; jj < 4; ++jj) mx = fmaxf(mx, s[kt][qt][jj]);
        mx = fmaxf(mx, __shfl_xor(mx, 16)); mx = fmaxf(mx, __shfl_xor(mx, 32));
        mn = fmaxf(mrow[qt], mx);
        alpha = __builtin_amdgcn_exp2f(mrow[qt] - mn);
        UNROLL for (int kt = 0; kt < 4; ++kt) UNROLL for (int jj = 0; jj < 4; ++jj) { const float pv = __builtin_amdgcn_exp2f(s[kt][qt][jj] - mn); s[kt][qt][jj] = pv; ls += pv; }
      } else {
        float mx = -INFINITY;
        UNROLL for (int kt = 0; kt < 4; ++kt) UNROLL for (int jj = 0; jj < 4; ++jj) mx = fmaxf(mx, s[kt][qt][jj]);
        mx = fmaxf(mx, __shfl_xor(mx, 16)); mx = fmaxf(mx, __shfl_xor(mx, 32));
        mn = fmaxf(mrow[qt], mx * cs);
        alpha = __builtin_amdgcn_exp2f(mrow[qt] - mn);
        UNROLL for (int kt = 0; kt < 4; ++kt) UNROLL for (int jj = 0; jj < 4; ++jj) { const float pv = __builtin_amdgcn_exp2f(fmaf(s[kt][qt][jj], cs, -mn)); s[kt][qt][jj] = pv; ls += pv; }
      }
      mrow[qt] = mn;
      lrow[qt] = lrow[qt] * alpha + ls;
      if (__any(alpha != 1.f)) { UNROLL for (int dt = 0; dt < 8; ++dt) o[dt][qt] *= alpha; }
    }
    bf16x8 pf[2][QT];
    UNROLL for (int g = 0; g < 2; ++g) UNROLL for (int qt = 0; qt < QT; ++qt) pf[g][qt] = cat8(pack4(s[2 * g][qt]), pack4(s[2 * g + 1][qt]));
    {
      const unsigned vad = sbase + (it & 1) * 35840 + 17408 + r * 144 + q * 8;
      bf16x8 vf[4];
#define AT_RDV(F, SLOT)                                                                                         \
      {                                                                                                         \
        const unsigned ad_ = vad + ((F) >> 1) * 2304;                                                           \
        if (((F) & 1) == 0) asm volatile("ds_read2_b64 %0, %1 offset1:4" : "=v"(vf[SLOT]) : "v"(ad_) : "memory");          \
        else asm volatile("ds_read2_b64 %0, %1 offset0:8 offset1:12" : "=v"(vf[SLOT]) : "v"(ad_) : "memory");   \
      }
#define AT_WAITV(N, SLOT) asm volatile("s_waitcnt lgkmcnt(" #N ")" : "+v"(vf[SLOT]) : : "memory")
      AT_RDV(0, 0) AT_RDV(1, 1) AT_RDV(2, 2) AT_RDV(3, 3)
      UNROLL for (int f = 0; f < 16; ++f) {
        const int dt = f >> 1, g = f & 1, sl = f & 3;
        if (f < 13) { AT_WAITV(3, sl); } else if (f == 13) { AT_WAITV(2, sl); } else if (f == 14) { AT_WAITV(1, sl); } else { AT_WAITV(0, sl); }
        UNROLL for (int qt = 0; qt < QT; ++qt) o[dt][qt] = MFMA16(vf[sl], pf[g][qt], o[dt][qt]);
        if (f + 4 < 16) AT_RDV(f + 4, sl)
      }
#undef AT_RDV
#undef AT_WAITV
    }
    if (it + 1 < ntiles) {
      bf* Kw = (bf*)smem + ((it + 1) & 1) * 17920; bf* Vw = Kw + 64 * 136;
      UNROLL for (int i = 0; i < 4; ++i) { *(bf16x8*)(Kw + krow * 136 + kseg * 32 + i * 8) = kr_[i]; *(bf16x8*)(Vw + vrow * 72 + vhalf * 32 + i * 8) = vr_[i]; }
    }
    half_barrier(hbar, hgen, lane);
  }
  UNROLL for (int qt = 0; qt < QT; ++qt) {
    float l = lrow[qt];
    l += __shfl_xor(l, 16); l += __shfl_xor(l, 32);
    const float inv = 1.f / l;
    UNROLL for (int dt = 0; dt < 8; ++dt) {
      f32x4 v = o[dt][qt]; v *= inv;
      *(s16x4*)(Q + ooff + (size_t)(w * 16 * QT + qt * 16 + r) * PLD + dt * 16 + q * 4) = pack4(v);
    }
  }
}

DI void attn_item(char* smem, const Params& p, int layer, int item, int ooff) {
  const bool even = !(layer & 1); const int j = layer >> 1;
  bf* P = (bf*)(p.ws + OFF_P);
  const bf* KB = (const bf*)(p.ws + OFF_KB);
  const bf* VT = (const bf*)(p.ws + OFF_VT);
  if (even) {
    if (item < 1024) {
      const int b = item >> 7, qt = (item & 127) >> 2, hq = item & 3, kvh = hq >> 1;
      const size_t slot = (size_t)16 * 2 * 256 * 128 + (size_t)(b * 2 + kvh) * 4608 * 128;
      attn_tile<2, 0>(smem, P + (size_t)(TCTX + b * 4096 + qt * 128) * PLD + 2048 + hq * 128, ooff, KB + slot, VT + slot, 4608, 72, 0, 0, nullptr);
    } else if (item < 1152) {
      const int it = item - 1024, seq = it >> 3, qt = (it >> 2) & 1, hq = it & 3, kvh = hq >> 1;
      const size_t slot = (size_t)(seq * 2 + kvh) * 256 * 128;
      attn_tile<2, 0>(smem, P + (size_t)(seq * 256 + qt * 128) * PLD + 2048 + hq * 128, ooff, KB + slot, VT + slot, 256, 4, 0, 0, nullptr);
    }
  } else {
    if (item < 2048) {
      const int b = item >> 8, row = (item >> 2) & 63, h = item & 3;
      const size_t slot = (size_t)16 * 4 * 256 * 128 + (size_t)(b * 4 + h) * 4608 * 128;
      int r0 = row - 4; r0 = r0 < 0 ? 0 : (r0 > 56 ? 56 : r0);
      attn_tile<1, 1>(smem, P + (size_t)(TCTX + b * 4096 + row * 64) * PLD + 1536 + h * 128, ooff, KB + slot, VT + slot, 4608, 16, r0, row,
                      p.rpb + (size_t)(j * 4 + h) * 15 * 31);
    } else {
      const int it = item - 2048, seq = it >> 4, qt = (it >> 2) & 3, h = it & 3;
      const size_t slot = (size_t)(seq * 4 + h) * 256 * 128;
      attn_tile<1, 0>(smem, P + (size_t)(seq * 256 + qt * 64) * PLD + 1536 + h * 128, ooff, KB + slot, VT + slot, 256, 4, 0, 0, nullptr);
    }
  }
}

DI void gdn_prep_item(char* smem, const Params& p, int item) {
  const int cgk = item >> 1, d = item & 1;
  const int tid = tid_(), lane = tid & 63, w = tid >> 6, r = lane & 15, q = lane >> 4;
  float* Am = (float*)smem + w * (64 * 68 + 128);
  float* gcs = Am + 64 * 68; float* bes = gcs + 64;
  const float* bg = (const float*)(p.ws + OFF_BG);
  const bf* X = (const bf*)(p.ws + OFF_RX);
  const int prob = (cgk * 2 + d) * 4 + w;
  {
    const int tokl = cgk * 64 + (d ? 63 - lane : lane);
    const float g = bg[(size_t)tokl * 16 + 8 + d * 4 + w], be = bg[(size_t)tokl * 16 + d * 4 + w];
    float gc = g;
    UNROLL for (int off = 1; off < 64; off <<= 1) { const float t = __shfl_up(gc, off); if (lane >= off) gc += t; }
    gcs[lane] = gc; bes[lane] = be;
    ((float*)(p.ws + OFF_GC))[(size_t)prob * 64 + lane] = gc;
  }
  bf16x8 kf[4][4];
  UNROLL for (int t = 0; t < 4; ++t) {
    const int i = t * 16 + r;
    const int tk = cgk * 64 + (d ? 63 - i : i);
    UNROLL for (int ks = 0; ks < 4; ++ks) kf[t][ks] = *(const bf16x8*)(X + (size_t)tk * 1536 + 512 + w * 128 + ks * 32 + q * 8);
  }
  __syncthreads();
  UNROLL for (int it = 0; it < 4; ++it) UNROLL for (int jt = 0; jt < 4; ++jt) {
    if (jt <= it) {
      f32x4 acc = f32x4{0.f, 0.f, 0.f, 0.f};
      UNROLL for (int ks = 0; ks < 4; ++ks) acc = MFMA16(kf[it][ks], kf[jt][ks], acc);
      UNROLL for (int jj = 0; jj < 4; ++jj) {
        const int i = it * 16 + q * 4 + jj, jx = jt * 16 + r;
        Am[i * 68 + jx] = (jx < i) ? bes[i] * acc[jj] * __expf(gcs[i] - gcs[jx]) : 0.f;
      }
    }
  }
  __syncthreads();
  for (int i0 = 0; i0 < 64; i0 += 4) {
    float a0 = (i0 == lane) ? 1.f : 0.f, a1 = (i0 + 1 == lane) ? 1.f : 0.f, a2 = (i0 + 2 == lane) ? 1.f : 0.f, a3 = (i0 + 3 == lane) ? 1.f : 0.f;
    _Pragma("unroll 4") for (int jx = 0; jx < i0; jx += 4) {
      const float x0 = Am[jx * 68 + lane], x1 = Am[(jx + 1) * 68 + lane], x2 = Am[(jx + 2) * 68 + lane], x3 = Am[(jx + 3) * 68 + lane];
      const float4 r0 = *(const float4*)(Am + i0 * 68 + jx), r1 = *(const float4*)(Am + (i0 + 1) * 68 + jx);
      const float4 r2 = *(const float4*)(Am + (i0 + 2) * 68 + jx), r3 = *(const float4*)(Am + (i0 + 3) * 68 + jx);
      a0 -= r0.x * x0 + r0.y * x1 + r0.z * x2 + r0.w * x3;
      a1 -= r1.x * x0 + r1.y * x1 + r1.z * x2 + r1.w * x3;
      a2 -= r2.x * x0 + r2.y * x1 + r2.z * x2 + r2.w * x3;
      a3 -= r3.x * x0 + r3.y * x1 + r3.z * x2 + r3.w * x3;
    }
    const float4 t1 = *(const float4*)(Am + (i0 + 1) * 68 + i0), t2 = *(const float4*)(Am + (i0 + 2) * 68 + i0), t3 = *(const float4*)(Am + (i0 + 3) * 68 + i0);
    a1 -= t1.x * a0;
    a2 -= t2.x * a0 + t2.y * a1;
    a3 -= t3.x * a0 + t3.y * a1 + t3.z * a2;
    Am[i0 * 68 + lane] = a0; Am[(i0 + 1) * 68 + lane] = a1; Am[(i0 + 2) * 68 + lane] = a2; Am[(i0 + 3) * 68 + lane] = a3;
  }
  bf* Ti = (bf*)(p.ws + OFF_TINV) + (size_t)prob * 4096;
  for (int i = 0; i < 64; ++i) Ti[i * 64 + lane] = f2bf(Am[i * 68 + lane]);
}

DI void gdn_scan_item(char* smem, const Params& p, int j, int item) {
  const int tid = tid_(), lane = tid & 63, w = tid >> 6, r = lane & 15, q = lane >> 4;
  const bool lat = item < 256;
  const int it0 = lat ? item : item - 256;
  const int sq = it0 >> 5, h = (it0 >> 3) & 3, d = (it0 >> 2) & 1, sl = it0 & 3;
  const int NC = lat ? 64 : 4;
  const int cgbase = lat ? 64 + sq * 64 : sq * 4;
  bf* Kc = (bf*)smem;
  bf* KdT = Kc + 64 * 136;
  bf* St = KdT + 128 * 72;
  bf* RT = St + 32 * 136;
  bf* VnT = RT + 32 * 72;
  bf* Vc = VnT + 32 * 72;
  float* gcs = (float*)(Vc + 64 * 40); float* bes = gcs + 64;
  bf* VsT = (bf*)(bes + 64);
  const bf* X = (const bf*)(p.ws + OFF_RX);
  const float* bg = (const float*)(p.ws + OFF_BG);
  const float* GC = (const float*)(p.ws + OFF_GC);
  const bf* TINV = (const bf*)(p.ws + OFF_TINV);
  bf* P = (bf*)(p.ws + OFF_P);
  f32x4 accs[2][2];
  UNROLL for (int mt = 0; mt < 2; ++mt) UNROLL for (int nt = 0; nt < 2; ++nt) {
    UNROLL for (int jj = 0; jj < 4; ++jj) {
      const int dk = (2 * w + mt) * 16 + q * 4 + jj, dv = sl * 32 + nt * 16 + r;
      accs[mt][nt][jj] = lat ? p.state_gdn[((size_t)(((sq * 2 + j) * 2 + d) * 4 + h) * 128 + dk) * 128 + dv] : 0.f;
    }
    *(s16x4*)(St + (nt * 16 + r) * 136 + (2 * w + mt) * 16 + q * 4) = pack4(accs[mt][nt]);
  }
  bf16x8 pkv[4], pvv, qfr[4], tif[2];
  float pgc = 0.f, pbe = 0.f;
#define GDN_LOAD_STAGE(nn)                                                                                   \
  {                                                                                                          \
    const int tc_ = d ? NC - 1 - (nn) : (nn);                                                                \
    const int cg_ = cgbase + tc_;                                                                            \
    const int pr_ = (cg_ * 2 + d) * 4 + h;                                                                   \
    const int i_ = tid & 63, seg_ = tid >> 6;                                                                 \
    const int tk_ = cg_ * 64 + (d ? 63 - i_ : i_);                                                           \
    UNROLL for (int ii = 0; ii < 4; ++ii) pkv[ii] = *(const bf16x8*)(X + (size_t)tk_ * 1536 + 512 + h * 128 + seg_ * 32 + ii * 8); \
    pvv = *(const bf16x8*)(X + (size_t)tk_ * 1536 + 1024 + h * 128 + sl * 32 + seg_ * 8);                    \
    if (tid < 64) {                                                                                          \
      pgc = GC[(size_t)pr_ * 64 + tid];                                                                      \
      pbe = bg[(size_t)(cg_ * 64 + (d ? 63 - tid : tid)) * 16 + d * 4 + h];                                  \
    }                                                                                                        \
  }
#define GDN_LOAD_Q(nn)                                                                                       \
  {                                                                                                          \
    const int tc_ = d ? NC - 1 - (nn) : (nn);                                                                \
    const int cg_ = cgbase + tc_;                                                                            \
    const int iq_ = 16 * w + r;                                                                              \
    const int tq_ = cg_ * 64 + (d ? 63 - iq_ : iq_);                                                         \
    UNROLL for (int ks = 0; ks < 4; ++ks) qfr[ks] = *(const bf16x8*)(X + (size_t)tq_ * 1536 + h * 128 + ks * 32 + q * 8); \
  }
#define GDN_LOAD_T(nn)                                                                                       \
  {                                                                                                          \
    const int tc_ = d ? NC - 1 - (nn) : (nn);                                                                \
    const int pr_ = ((cgbase + tc_) * 2 + d) * 4 + h;                                                        \
    const int iq_ = 16 * w + r;                                                                              \
    UNROLL for (int k2 = 0; k2 < 2; ++k2) tif[k2] = *(const bf16x8*)(TINV + ((size_t)pr_ * 64 + iq_) * 64 + k2 * 32 + q * 8); \
  }
  GDN_LOAD_STAGE(0) GDN_LOAD_Q(0) GDN_LOAD_T(0)
  for (int n = 0; n < NC; ++n) {
    const int tc = d ? NC - 1 - n : n;
    const int cgk = cgbase + tc;
    {
      const int i = tid & 63, seg = tid >> 6;
      UNROLL for (int ii = 0; ii < 4; ++ii) {
        const bf16x8 kv = pkv[ii];
        *(bf16x8*)(Kc + i * 136 + seg * 32 + ii * 8) = kv;
        UNROLL for (int e = 0; e < 8; ++e) KdT[(seg * 32 + ii * 8 + e) * 72 + i] = (bf)kv[e];
      }
      *(bf16x8*)(Vc + i * 40 + seg * 8) = pvv;
      if (tid < 64) { gcs[tid] = pgc; bes[tid] = pbe; }
    }
    if (n + 1 < NC) GDN_LOAD_STAGE(n + 1)
    bar_lds();
    f32x4 ksa[2], qsa[2], qk[4];
    UNROLL for (int nt = 0; nt < 2; ++nt) { ksa[nt] = f32x4{0.f, 0.f, 0.f, 0.f}; qsa[nt] = f32x4{0.f, 0.f, 0.f, 0.f}; }
    UNROLL for (int jt = 0; jt < 4; ++jt) qk[jt] = f32x4{0.f, 0.f, 0.f, 0.f};
    UNROLL for (int ks = 0; ks < 4; ++ks) {
      const bf16x8 ka = *(const bf16x8*)(Kc + (16 * w + r) * 136 + ks * 32 + q * 8);
      UNROLL for (int nt = 0; nt < 2; ++nt) {
        const bf16x8 sb = *(const bf16x8*)(St + (nt * 16 + r) * 136 + ks * 32 + q * 8);
        ksa[nt] = MFMA16(ka, sb, ksa[nt]);
        qsa[nt] = MFMA16(qfr[ks], sb, qsa[nt]);
      }
      UNROLL for (int jt = 0; jt < 4; ++jt) {
        const bf16x8 kj = *(const bf16x8*)(Kc + (jt * 16 + r) * 136 + ks * 32 + q * 8);
        qk[jt] = MFMA16(kj, qfr[ks], qk[jt]);
      }
    }
    UNROLL for (int nt = 0; nt < 2; ++nt) {
      f32x4 rv;
      UNROLL for (int jj = 0; jj < 4; ++jj) {
        const int ii = 16 * w + q * 4 + jj;
        rv[jj] = bes[ii] * (bf2f(Vc[ii * 40 + nt * 16 + r]) - __expf(gcs[ii]) * ksa[nt][jj]);
      }
      *(s16x4*)(RT + (nt * 16 + r) * 72 + 16 * w + q * 4) = pack4(rv);
    }
    bf16x8 qkf[2];
    {
      const int ii = 16 * w + r; const float gi = gcs[ii];
      UNROLL for (int s2 = 0; s2 < 2; ++s2) UNROLL for (int e = 0; e < 8; ++e) {
        const int jt = 2 * s2 + (e >> 2);
        const int jx = jt * 16 + q * 4 + (e & 3);
        const float val = (jx <= ii) ? qk[jt][e & 3] * __expf(gi - gcs[jx]) : 0.f;
        qkf[s2][e] = (short)f2bf(val);
      }
    }
    if (n + 1 < NC) GDN_LOAD_Q(n + 1)
    bar_lds();
    f32x4 vn[2];
    UNROLL for (int nt = 0; nt < 2; ++nt) {
      vn[nt] = f32x4{0.f, 0.f, 0.f, 0.f};
      UNROLL for (int k2 = 0; k2 < 2; ++k2) {
        const bf16x8 rb = *(const bf16x8*)(RT + (nt * 16 + r) * 72 + k2 * 32 + q * 8);
        vn[nt] = MFMA16(tif[k2], rb, vn[nt]);
      }
      *(s16x4*)(VnT + (nt * 16 + r) * 72 + 16 * w + q * 4) = pack4(vn[nt]);
      f32x4 vs;
      UNROLL for (int jj = 0; jj < 4; ++jj) vs[jj] = vn[nt][jj] * __expf(gcs[63] - gcs[16 * w + q * 4 + jj]);
      *(s16x4*)(VsT + (nt * 16 + r) * 72 + 16 * w + q * 4) = pack4(vs);
    }
    if (n + 1 < NC) GDN_LOAD_T(n + 1)
    bar_lds();
    UNROLL for (int nt = 0; nt < 2; ++nt) {
      f32x4 oa = f32x4{0.f, 0.f, 0.f, 0.f};
      UNROLL for (int s2 = 0; s2 < 2; ++s2) {
        const s16x4 lo = *(const s16x4*)(VnT + (nt * 16 + r) * 72 + s2 * 32 + q * 4);
        const s16x4 hi = *(const s16x4*)(VnT + (nt * 16 + r) * 72 + s2 * 32 + 16 + q * 4);
        oa = MFMA16(qkf[s2], cat8(lo, hi), oa);
      }
      UNROLL for (int jj = 0; jj < 4; ++jj) {
        const int i = 16 * w + q * 4 + jj;
        const int tk = cgk * 64 + (d ? 63 - i : i);
        const float ov = __expf(gcs[i]) * qsa[nt][jj] + oa[jj];
        P[(size_t)tk * PLD + d * 512 + h * 128 + sl * 32 + nt * 16 + r] = f2bf(ov);
      }
    }
    {
      const float gt = __expf(gcs[63]);
      UNROLL for (int mt = 0; mt < 2; ++mt) UNROLL for (int nt = 0; nt < 2; ++nt) {
        f32x4 a = accs[mt][nt]; a *= gt;
        UNROLL for (int k2 = 0; k2 < 2; ++k2) {
          const bf16x8 ka = *(const bf16x8*)(KdT + ((2 * w + mt) * 16 + r) * 72 + k2 * 32 + q * 8);
          const bf16x8 vb = *(const bf16x8*)(VsT + (nt * 16 + r) * 72 + k2 * 32 + q * 8);
          a = MFMA16(ka, vb, a);
        }
        accs[mt][nt] = a;
        *(s16x4*)(St + (nt * 16 + r) * 136 + (2 * w + mt) * 16 + q * 4) = pack4(a);
      }
    }
    bar_lds();
  }
  if (!lat) {
    UNROLL for (int mt = 0; mt < 2; ++mt) UNROLL for (int nt = 0; nt < 2; ++nt) UNROLL for (int jj = 0; jj < 4; ++jj) {
      const int dk = (2 * w + mt) * 16 + q * 4 + jj, dv = sl * 32 + nt * 16 + r;
      p.out[OUT_GDN + ((size_t)(((sq * 2 + j) * 2 + d) * 4 + h) * 128 + dk) * 128 + dv] = accs[mt][nt][jj];
    }
  }
}

DI void ssd_scan_item(char* smem, const Params& p, int j, int item) {
  const int tid = tid_(), lane = tid & 63, w = tid >> 6, r = lane & 15, q = lane >> 4;
  const bool lat = item < 256;
  const int it0 = lat ? item : item - 256;
  const int sq = it0 >> 5, hh = (it0 >> 2) & 7, d = (it0 >> 1) & 1, ps = it0 & 1;
  const int NC = lat ? 64 : 4;
  const int cgbase = lat ? 64 + sq * 64 : sq * 4;
  const int gq = hh >> 2;
  bf* Bc = (bf*)smem;
  bf* BT = Bc + 64 * 136;
  bf* XT = BT + 128 * 72;
  bf* XdT = XT + 32 * 72;
  bf* Hb = XdT + 32 * 72;
  float* css = (float*)(Hb + 32 * 136); float* dts = css + 64;
  const bf* X = (const bf*)(p.ws + OFF_RX);
  const float* bg = (const float*)(p.ws + OFF_BG);
  bf* P = (bf*)(p.ws + OFF_P);
  const float a = -expf(p.ssd_alog[j * 16 + d * 8 + hh]);
  f32x4 acch[2][2];
  UNROLL for (int ntl = 0; ntl < 2; ++ntl) UNROLL for (int mt = 0; mt < 2; ++mt) {
    f32x4 v = f32x4{0.f, 0.f, 0.f, 0.f};
    if (lat) {
      const float4 t = *(const float4*)(p.state_ssd + ((size_t)(((sq * 2 + j) * 2 + d) * 8 + hh) * 64 + ps * 32 + mt * 16 + r) * 128 + (2 * w + ntl) * 16 + q * 4);
      v[0] = t.x; v[1] = t.y; v[2] = t.z; v[3] = t.w;
    }
    acch[ntl][mt] = v;
    *(s16x4*)(Hb + (mt * 16 + r) * 136 + (2 * w + ntl) * 16 + q * 4) = pack4(v);
  }
  bf16x8 pbv[4], pxv, cf[4];
  float pdt = 0.f;
#define SSD_LOAD_STAGE(nn)                                                                                   \
  {                                                                                                          \
    const int tc_ = d ? NC - 1 - (nn) : (nn);                                                                \
    const int cg_ = cgbase + tc_;                                                                            \
    pdt = bg[(size_t)(cg_ * 64 + (d ? 63 - lane : lane)) * 16 + d * 8 + hh];                                 \
    const int i_ = tid & 63, seg_ = tid >> 6;                                                                 \
    const int tk_ = cg_ * 64 + (d ? 63 - i_ : i_);                                                           \
    UNROLL for (int ii = 0; ii < 4; ++ii) pbv[ii] = *(const bf16x8*)(X + (size_t)tk_ * 1024 + 512 + gq * 128 + seg_ * 32 + ii * 8); \
    pxv = *(const bf16x8*)(X + (size_t)tk_ * 1024 + hh * 64 + ps * 32 + seg_ * 8);                           \
  }
#define SSD_LOAD_C(nn)                                                                                       \
  {                                                                                                          \
    const int tc_ = d ? NC - 1 - (nn) : (nn);                                                                \
    const int cg_ = cgbase + tc_;                                                                            \
    const int l_ = 16 * w + r;                                                                               \
    const int tq_ = cg_ * 64 + (d ? 63 - l_ : l_);                                                           \
    UNROLL for (int ks = 0; ks < 4; ++ks) cf[ks] = *(const bf16x8*)(X + (size_t)tq_ * 1024 + 768 + gq * 128 + ks * 32 + q * 8); \
  }
  SSD_LOAD_STAGE(0) SSD_LOAD_C(0)
  for (int n = 0; n < NC; ++n) {
    const int tc = d ? NC - 1 - n : n;
    const int cgk = cgbase + tc;
    float cs, dtl;
    {
      dtl = pdt;
      cs = dtl * a;
      UNROLL for (int off = 1; off < 64; off <<= 1) { const float t = __shfl_up(cs, off); if (lane >= off) cs += t; }
      if (w == 0) { css[lane] = cs; dts[lane] = dtl; }
    }
    {
      const int i = tid & 63, seg = tid >> 6;
      const float cs_i = __shfl(cs, i & 63), dt_i = __shfl(dtl, i & 63), cs_l = __shfl(cs, 63);
      const float xs = dt_i * __expf(cs_l - cs_i);
      UNROLL for (int ii = 0; ii < 4; ++ii) {
        const bf16x8 bv = pbv[ii];
        *(bf16x8*)(Bc + i * 136 + seg * 32 + ii * 8) = bv;
        UNROLL for (int e = 0; e < 8; ++e) BT[(seg * 32 + ii * 8 + e) * 72 + i] = (bf)bv[e];
      }
      const bf16x8 xv = pxv;
      UNROLL for (int e = 0; e < 8; ++e) {
        XT[(seg * 8 + e) * 72 + i] = (bf)xv[e];
        XdT[(seg * 8 + e) * 72 + i] = f2bf(bf2f((bf)xv[e]) * xs);
      }
    }
    if (n + 1 < NC) SSD_LOAD_STAGE(n + 1)
    bar_lds();
    f32x4 gT[4], yo[2];
    UNROLL for (int st = 0; st < 4; ++st) gT[st] = f32x4{0.f, 0.f, 0.f, 0.f};
    UNROLL for (int mt = 0; mt < 2; ++mt) yo[mt] = f32x4{0.f, 0.f, 0.f, 0.f};
    UNROLL for (int ks = 0; ks < 4; ++ks) {
      UNROLL for (int st = 0; st < 4; ++st) {
        const bf16x8 bs = *(const bf16x8*)(Bc + (st * 16 + r) * 136 + ks * 32 + q * 8);
        gT[st] = MFMA16(bs, cf[ks], gT[st]);
      }
      UNROLL for (int mt = 0; mt < 2; ++mt) {
        const bf16x8 hb = *(const bf16x8*)(Hb + (mt * 16 + r) * 136 + ks * 32 + q * 8);
        yo[mt] = MFMA16(cf[ks], hb, yo[mt]);
      }
    }
    if (n + 1 < NC) SSD_LOAD_C(n + 1)
    bf16x8 mf[2];
    {
      const int ll = 16 * w + r; const float cl = css[ll];
      UNROLL for (int s2 = 0; s2 < 2; ++s2) UNROLL for (int e = 0; e < 8; ++e) {
        const int st = 2 * s2 + (e >> 2);
        const int sx = st * 16 + q * 4 + (e & 3);
        const float val = (sx <= ll) ? gT[st][e & 3] * __expf(cl - css[sx]) * dts[sx] : 0.f;
        mf[s2][e] = (short)f2bf(val);
      }
    }
    UNROLL for (int mt = 0; mt < 2; ++mt) {
      f32x4 ya;
      UNROLL for (int jj = 0; jj < 4; ++jj) ya[jj] = yo[mt][jj] * __expf(css[16 * w + q * 4 + jj]);
      UNROLL for (int s2 = 0; s2 < 2; ++s2) {
        const s16x4 lo = *(const s16x4*)(XT + (mt * 16 + r) * 72 + s2 * 32 + q * 4);
        const s16x4 hi = *(const s16x4*)(XT + (mt * 16 + r) * 72 + s2 * 32 + 16 + q * 4);
        ya = MFMA16(mf[s2], cat8(lo, hi), ya);
      }
      UNROLL for (int jj = 0; jj < 4; ++jj) {
        const int l = 16 * w + q * 4 + jj;
        const int tk = cgk * 64 + (d ? 63 - l : l);
        P[(size_t)tk * PLD + 512 + d * 512 + hh * 64 + ps * 32 + mt * 16 + r] = f2bf(ya[jj]);
      }
    }
    {
      const float cd = __expf(css[63]);
      UNROLL for (int ntl = 0; ntl < 2; ++ntl) UNROLL for (int mt = 0; mt < 2; ++mt) {
        f32x4 v = acch[ntl][mt]; v *= cd;
        UNROLL for (int k2 = 0; k2 < 2; ++k2) {
          const bf16x8 ba = *(const bf16x8*)(BT + ((2 * w + ntl) * 16 + r) * 72 + k2 * 32 + q * 8);
          const bf16x8 xb = *(const bf16x8*)(XdT + (mt * 16 + r) * 72 + k2 * 32 + q * 8);
          v = MFMA16(ba, xb, v);
        }
        acch[ntl][mt] = v;
      }
    }
    bar_lds();
    UNROLL for (int ntl = 0; ntl < 2; ++ntl) UNROLL for (int mt = 0; mt < 2; ++mt)
      *(s16x4*)(Hb + (mt * 16 + r) * 136 + (2 * w + ntl) * 16 + q * 4) = pack4(acch[ntl][mt]);
  }
  if (!lat) {
    UNROLL for (int ntl = 0; ntl < 2; ++ntl) UNROLL for (int mt = 0; mt < 2; ++mt) {
      const f32x4 v = acch[ntl][mt];
      *(float4*)(p.out + OUT_SSD + ((size_t)(((sq * 2 + j) * 2 + d) * 8 + hh) * 64 + ps * 32 + mt * 16 + r) * 128 + (2 * w + ntl) * 16 + q * 4) =
          make_float4(v[0], v[1], v[2], v[3]);
    }
  }
}

DI void gate_item(const Params& p, int layer, int item) {
  const bool even = !(layer & 1); const int j = layer >> 1;
  const int tid = tid_(), lane = tid & 63, w = tid >> 6;
  bf* P = (bf*)(p.ws + OFF_P);
  for (int tt = 0; tt < 4; ++tt) {
    const int tok = item * 16 + w * 4 + tt;
    bf* pr = P + (size_t)tok * PLD;
    if (even) {
      for (int h = 0; h < 4; ++h) {
        const int c = h * 128 + lane * 2;
        const unsigned u0 = *(const unsigned*)(pr + c), u1 = *(const unsigned*)(pr + 512 + c), uz = *(const unsigned*)(pr + 1536 + c);
        const float o0 = bflo(u0) + bflo(u1), o1 = bfhi(u0) + bfhi(u1);
        const float ss = wave_sum(o0 * o0 + o1 * o1);
        const float rstd = rsqrtf(ss * (1.f / 128.f) + EPSF);
        const float2 gn = *(const float2*)(p.gdn_norm + j * 128 + lane * 2);
        *(unsigned*)(pr + c) = packbf(o0 * rstd * gn.x * silu(bflo(uz)), o1 * rstd * gn.y * silu(bfhi(uz)));
      }
    } else {
      const int c = lane * 8;
      float y0[8], y1[8], xh[8], z[8], y[8];
      unpack8(*(const bf16x8*)(pr + 512 + c), y0);
      unpack8(*(const bf16x8*)(pr + 1024 + c), y1);
      unpack8(*(const bf16x8*)(pr + c), z);
      unpack8(*(const bf16x8*)((const bf*)(p.ws + OFF_RX) + (size_t)tok * 1024 + c), xh);
      const float dsk = p.ssd_d[j * 8 + (c >> 6)];
      float ss = 0.f;
      UNROLL for (int e = 0; e < 8; ++e) { y[e] = (y0[e] + y1[e] + xh[e] * dsk) * silu(z[e]); ss += y[e] * y[e]; }
      ss = wave_sum(ss);
      const float rstd = rsqrtf(ss * (1.f / 512.f) + EPSF);
      const float* sn = p.ssd_norm + j * 512 + c;
      bf16x8 o;
      UNROLL for (int e = 0; e < 8; ++e) o[e] = (short)f2bf(y[e] * rstd * sn[e]);
      *(bf16x8*)(pr + 512 + c) = o;
    }
  }
}


#define XB_TMO      128
#define XB_XCNT(j)  (256  + 64 * (j))
#define XB_XSUB(j)  (1280 + 64 * (j))
#define XB_XGEN(j)  (2304 + 64 * (j))
#define XB_TOP      3328
#define XB_TOPGEN   3392
#define XB_SPIN_CAP (1u << 20)
DI unsigned xb_ld(unsigned* p)              { return __hip_atomic_load(p, __ATOMIC_RELAXED, __HIP_MEMORY_SCOPE_AGENT); }
DI unsigned xb_add(unsigned* p, unsigned v) { return __hip_atomic_fetch_add(p, v, __ATOMIC_RELAXED, __HIP_MEMORY_SCOPE_AGENT); }
#define XB_SPIN(cond, bar) do { unsigned _sp = 0; while (cond) { __builtin_amdgcn_s_sleep(1); \
    if ((++_sp & 255u) == 0u) { if (xb_ld(&(bar)[XB_TMO])) break; if (_sp > XB_SPIN_CAP) { atomicAdd(&(bar)[XB_TMO], 1u); break; } } } } while (0)
DI void xcd_barrier_complete(unsigned* bar, unsigned x, unsigned& nloc, unsigned& nx) {
  const unsigned G = gridDim.x;
  unsigned sum, cnt, mine, sp = 0u;
  for (;;) {
    sum = 0u; cnt = 0u; mine = 0u;
    UNROLL for (unsigned jx = 0; jx < 16; ++jx) { const unsigned c = xb_ld(&bar[XB_XCNT(jx)]); sum += c; cnt += (c > 0u) ? 1u : 0u; mine = (jx == x) ? c : mine; }
    if (sum == G) break;
    __builtin_amdgcn_s_sleep(1);
    if ((++sp & 255u) == 0u) { if (xb_ld(&bar[XB_TMO])) break; if (sp > XB_SPIN_CAP) { atomicAdd(&bar[XB_TMO], 1u); break; } }
  }
  nloc = mine > 0u ? mine : 1u; nx = cnt > 0u ? cnt : 1u;
}
DI void xcd_barrier(unsigned* bar, unsigned x, volatile unsigned* st) {
  asm volatile("s_waitcnt vmcnt(0)" ::: "memory");
  __syncthreads();
  if (threadIdx.x == 0) {
    __builtin_amdgcn_s_waitcnt(0);
    unsigned nloc = st[0], nx = st[1];
    if (nloc == 0u) { xcd_barrier_complete(bar, x, nloc, nx); st[0] = nloc; st[1] = nx; }
    const unsigned old = xb_add(&bar[XB_XSUB(x)], 1u);
    const unsigned gen = old / nloc;
    if (old + 1u == (gen + 1u) * nloc) {
      __builtin_amdgcn_fence(__ATOMIC_RELEASE, "agent");
      asm volatile("s_waitcnt vmcnt(0)" ::: "memory");
      const unsigned og = xb_add(&bar[XB_TOP], 1u);
      const unsigned tg = og / nx;
      if (og + 1u == (tg + 1u) * nx) xb_add(&bar[XB_TOPGEN], 1u);
      else XB_SPIN(xb_ld(&bar[XB_TOPGEN]) == tg, bar);
      __builtin_amdgcn_fence(__ATOMIC_ACQUIRE, "agent");
      xb_add(&bar[XB_XGEN(x)], 1u);
      asm volatile("s_waitcnt vmcnt(0)" ::: "memory");
    } else {
      XB_SPIN(xb_ld(&bar[XB_XGEN(x)]) == gen, bar);
      __builtin_amdgcn_fence(__ATOMIC_ACQUIRE, "agent");
      asm volatile("s_waitcnt vmcnt(0)" ::: "memory");
    }
  }
  __syncthreads();
}
#define GRID_SEAM() { if (phase <= 2) grid.sync(); else xcd_barrier(xbar, xb_x, xb_st); }

#define FOR_ITEMS(N, ...)                                                               \
  {                                                                                     \
    const int n_items_ = (N);                                                           \
    for (;;) {                                                                          \
      __syncthreads();                                                                  \
      if (threadIdx.x == 0) s_item = atomicAdd(ctr + phase * 8, 1);                     \
      __syncthreads();                                                                  \
      const int item = 2 * s_item + half;     \
      if (item - half >= n_items_) break;                                               \
      if (item < n_items_) { __VA_ARGS__ }                                              \
    }                                                                                   \
    ++phase;                                                                            \
    GRID_SEAM()                                                                         \
  }

#define FOR_GEMM(MTOT, NP, NTN, EXTRA, ...)                                                   \
  {                                                                                     \
    constexpr int np_ = (NP), npx_ = (NTN) / (NP), mp_ = (MTOT) / (8 / (NP));              \
    constexpr int cnt_ = mp_ * npx_;                                                    \
    int xq_ = (int)(xcc_id() & 7u), tries_ = 0;                                         \
    for (;;) {                                                                          \
      __syncthreads();                                                                  \
      if (threadIdx.x == 0) {                                                           \
        int it_ = -1;                                                                   \
        while (tries_ < 8) {                                                            \
          const int li_ = atomicAdd(ctr + phase * 8 + xq_, 1);                          \
          if (li_ < cnt_) {                                                             \
            const int mt_ = (xq_ / np_) * mp_ + li_ / npx_;                             \
            const int nt_ = (xq_ % np_) * npx_ + li_ % npx_;                            \
            it_ = (mt_ << 6) | nt_;                                                     \
            break;                                                                      \
          } else if (li_ < cnt_ + (EXTRA)) {                                            \
            it_ = ((xq_ * (EXTRA) + li_ - cnt_) << 6) | 63;                             \
            break;                                                                      \
          }                                                                             \
          xq_ = (xq_ + 1) & 7; ++tries_;                                                \
        }                                                                               \
        s_item = it_;                                                                   \
      }                                                                                 \
      __syncthreads();                                                                  \
      const int item = s_item;                                                          \
      if (item < 0) break;                                                              \
      const int mt = item >> 6, nt = item & 63;                                         \
      __VA_ARGS__                                                                       \
    }                                                                                   \
    ++phase;                                                                            \
    GRID_SEAM()                                                                         \
  }

__global__ void __launch_bounds__(512) hybrid_dit_megakernel(Params p) {
  cg::grid_group grid = cg::this_grid();
  __shared__ __attribute__((aligned(16))) char smem_all[2 * SMEM_BYTES];
  const int half = threadIdx.x >> 8;
  char* smem = smem_all + half * SMEM_BYTES;
  __shared__ int s_item;
  int* ctr = (int*)(p.ws + OFF_CTR);
  int phase = 0;
  __shared__ unsigned xb_st_s[2];
  volatile unsigned* xb_st = xb_st_s;
  unsigned* xbar = (unsigned*)(p.ws + OFF_XBAR);
  const unsigned xb_x = xcc_id();
  if (threadIdx.x == 0) { xb_st[0] = 0u; xb_st[1] = 0u; (void)xb_add(&xbar[XB_XCNT(xb_x)], 1u); }
  __syncthreads();

  bf* RX = (bf*)(p.ws + OFF_RX);
  bf* P = (bf*)(p.ws + OFF_P);
  const bf* HB = (const bf*)(p.ws + OFF_H);

  FOR_ITEMS(3104 + 384 + 1, {
    if (item < 3104) convert_item(smem, p, 0, item);
    else if (item < 3488) mod_item(smem, p, item - 3104);
    else rope_item(p);
  })
  FOR_ITEMS(2304, { for (int tt = 0; tt < 4; ++tt) rowpass<0>(p, 0, item * 16 + (tid_() >> 6) * 4 + tt); })

  for (int layer = 0; layer < 4; ++layer) {
    const bool even = !(layer & 1);
    const int j = layer >> 1;
    FOR_GEMM(144, 4, 12, 18, {
      if (nt < 63) gemm512<256, 1, 1, 1>(smem_all, HB, HB, 0, 1 << 30, (const bf*)(p.ws + OFF_WIN), 3200, 1024, mt * 256, nt * 256, P, PLD);
      else gates_tile(HB, (const bf*)(p.ws + OFF_WIN), mt * 256, (float*)(p.ws + OFF_GATES));
    })
    {
      const int nkv = even ? (128 + 1152) : (256 + 2304);
      const int nq = even ? 2304 : 0;
      FOR_ITEMS(2304 + nkv + nq, {
        if (item < 2304) conv_item(p, layer, item);
        else if (item < 2304 + nkv) kvprep_item(smem, p, layer, item - 2304);
        else qprep_item(p, layer, item - 2304 - nkv);
      })
    }
#if PROBE == 3
    FOR_ITEMS(2304, { attn_item(smem, p, layer, item, even ? -1024 : 512); })
#endif
#if PROBE == 4
    if (even) { FOR_ITEMS(1152, { gdn_prep_item(smem, p, item); }) }
#endif
    if (even) {
      FOR_ITEMS(1152, { gdn_prep_item(smem, p, item); })
#if PROBE == 2
      FOR_ITEMS(768, { gdn_scan_item(smem, p, j, item); })
#endif
      FOR_ITEMS(768 + 1152, {
        const bool sc_ = item < 256 || item >= 256 + 1152;
        const int it2_ = item < 256 ? item : (item < 256 + 1152 ? item - 256 : item - 1152);
        if (sc_) gdn_scan_item(smem, p, j, it2_);
        else attn_item(smem, p, layer, it2_, 0);
      })
    } else {
#if PROBE == 2
      FOR_ITEMS(768, { ssd_scan_item(smem, p, j, item); })
#endif
      FOR_ITEMS(768 + 2304, {
        const bool sc_ = item < 256 || item >= 256 + 2304;
        const int it2_ = item < 256 ? item : (item < 256 + 2304 ? item - 256 : item - 2304);
        if (sc_) ssd_scan_item(smem, p, j, it2_);
        else attn_item(smem, p, layer, it2_, 0);
      })
    }
    FOR_ITEMS(2304, { gate_item(p, layer, item); })
    FOR_GEMM(144, 1, 8, 0, {
      gemm512<128, 1, 0, 0>(smem_all, P + (even ? 0 : 512), P + (even ? 2048 : 1536), PLD, 512, (const bf*)(p.ws + OFF_WOUT), 1024, 1024, mt * 256, nt * 128, RX, 1024);
    })
    FOR_ITEMS(2304, { for (int tt = 0; tt < 4; ++tt) rowpass<1>(p, layer, item * 16 + (tid_() >> 6) * 4 + tt); })
#if PROBE == 1
    FOR_GEMM(144, 8, 16, 0, {
      gemm512<256, 2, 1, 1>(smem_all, HB, HB, 0, 1 << 30, (const bf*)(p.ws + OFF_W1), 4096, 1024, mt * 256, nt * 256, P, 4096);
    })
#endif
#if PROBE == 5
    FOR_GEMM(144, 4, 8, 0, {
      gemm512<128, 1, 1, 1>(smem_all, P, P, 0, 1 << 30, (const bf*)(p.ws + OFF_W2), 1024, 4096, mt * 256, nt * 128, RX, 1024);
    })
#endif
    FOR_GEMM(144, 4, 16, 0, {
      gemm512<256, 2, 1, 1>(smem_all, HB, HB, 0, 1 << 30, (const bf*)(p.ws + OFF_W1), 4096, 1024, mt * 256, nt * 256, P, 4096);
    })
    FOR_GEMM(144, 4, 8, 0, {
      gemm512<128, 1, 1, 1>(smem_all, P, P, 0, 1 << 30, (const bf*)(p.ws + OFF_W2), 1024, 4096, mt * 256, nt * 128, RX, 1024);
    })
    {
      const int ncv = layer < 3 ? 3104 : 0;
      FOR_ITEMS(2304 + ncv, {
        if (item < 2304) { for (int tt = 0; tt < 4; ++tt) rowpass<2>(p, layer, item * 16 + (tid_() >> 6) * 4 + tt); }
        else convert_item(smem, p, layer + 1, item - 2304);
      })
    }
  }
}

extern "C" void kernel_launch(void* const* d_in, const int* in_sizes, int n_in, void* d_out, int out_size, void* d_ws,
                              size_t ws_size, hipStream_t stream) {
  (void)in_sizes; (void)n_in; (void)out_size;
  static int grid_blocks = 0;
  if (!grid_blocks) {
    int dev = 0, cus = 0, per_cu = 0;
    hipGetDevice(&dev);
    hipDeviceGetAttribute(&cus, hipDeviceAttributeMultiprocessorCount, dev);
    hipOccupancyMaxActiveBlocksPerMultiprocessor(&per_cu, hybrid_dit_megakernel, 512, 0);
    if (per_cu > 1) per_cu = 1;
    if (per_cu < 1) per_cu = 1;
    grid_blocks = cus * per_cu;
  }
  if (ws_size < WS_END) fprintf(stderr, "workspace too small: %zu < %zu\n", ws_size, (size_t)WS_END);
  Params p{};
  const float** f = (const float**)&p;
  for (int i = 0; i < 35; ++i) f[i] = (const float*)d_in[i];
  p.out = (float*)d_out;
  p.ws = (char*)d_ws;
  hipMemsetAsync((char*)d_ws + OFF_CTR, 0, 4096 + 16384, stream);
  void* args[] = {&p};
  hipError_t e = hipLaunchCooperativeKernel((void*)hybrid_dit_megakernel, dim3(grid_blocks), dim3(512), args, 0, stream);
  if (e != hipSuccess) fprintf(stderr, "cooperative launch failed: %s (grid %d)\n", hipGetErrorString(e), grid_blocks);
}
```
